# Optimizing an MI355X kernel written in HIP

```python
import math
import jax, jax.numpy as jnp
from jax import lax
import numpy as np

D_MODEL = 1024
BATCH = 2
SEQ = 16384
DEPTH = 4
DEC_BATCH = 32
DEC_SEQ = 2048
PAST_LEN = 128

N_MIXERS = 3
N_A = (DEPTH + 2) // 3
N_B = (DEPTH + 1) // 3
N_C = DEPTH // 3
FNET_GROUPS = 4
FNET_GROUP_DIM = D_MODEL // FNET_GROUPS
HEAD_DIM = 64
SWA_Q_HEADS = D_MODEL // HEAD_DIM
SWA_KV_HEADS = 4
SWA_GROUP = SWA_Q_HEADS // SWA_KV_HEADS
WINDOW = 128
BLOCK = 128
DIFF_HEADS = D_MODEL // (2 * HEAD_DIM)
D_DIFF = DIFF_HEADS * 2 * HEAD_DIM
D_FF = 2816
CONV_WIDTH = 3
ROPE_THETA = 10000.0
EPS = 1e-6
NEG = -1e30

kernel_name = "hybrid_fnet_swa_diffattn_encoder"


def rms_norm(x, g):
    xf = x.astype(jnp.float32)
    y = xf * lax.rsqrt(jnp.mean(xf * xf, axis=-1, keepdims=True) + EPS)
    return (y * g.astype(jnp.float32)).astype(x.dtype)


def rope_tables(seq):
    inv = 1.0 / (ROPE_THETA ** (jnp.arange(0, HEAD_DIM, 2, dtype=jnp.float32) / HEAD_DIM))
    ang = jnp.arange(seq, dtype=jnp.float32)[:, None] * inv[None, :]
    return jnp.cos(ang), jnp.sin(ang)


def apply_rope(x, cos, sin):
    half = HEAD_DIM // 2
    shp = (1, cos.shape[0]) + (1,) * (x.ndim - 3) + (half,)
    c = cos.reshape(shp)
    s = sin.reshape(shp)
    xf = x.astype(jnp.float32)
    x1, x2 = xf[..., :half], xf[..., half:]
    return jnp.concatenate([x1 * c - x2 * s, x2 * c + x1 * s], axis=-1).astype(x.dtype)


def fourier_mixer(h, w_o, b_o):
    B, S, D = h.shape
    hg = h.astype(jnp.float32).reshape(B, S, FNET_GROUPS, FNET_GROUP_DIM)
    f = jnp.fft.fftn(hg, axes=(1, 3), norm="ortho").real
    return f.reshape(B, S, D).astype(h.dtype) @ w_o + b_o


def windowed_gqa(h, w_qkv, q_g, k_g, sink, w_o, cos, sin):
    B, S, _ = h.shape
    nq = SWA_Q_HEADS * HEAD_DIM
    nkv = SWA_KV_HEADS * HEAD_DIM
    qkv = h @ w_qkv
    q = qkv[..., :nq].reshape(B, S, SWA_KV_HEADS, SWA_GROUP, HEAD_DIM)
    k = qkv[..., nq:nq + nkv].reshape(B, S, SWA_KV_HEADS, HEAD_DIM)
    v = qkv[..., nq + nkv:].reshape(B, S, SWA_KV_HEADS, HEAD_DIM)
    q = apply_rope(rms_norm(q, q_g), cos, sin)
    k = apply_rope(rms_norm(k, k_g), cos, sin)
    pad = ((0, 0), (BLOCK, BLOCK), (0, 0), (0, 0))
    kp = jnp.pad(k, pad)
    vp = jnp.pad(v, pad)
    nb = S // BLOCK
    qb = jnp.moveaxis(q.reshape(B, nb, BLOCK, SWA_KV_HEADS, SWA_GROUP, HEAD_DIM), 1, 0)
    sink_f = sink.astype(jnp.float32).reshape(SWA_KV_HEADS, SWA_GROUP)[None, :, :, None, None]
    scale = HEAD_DIM ** -0.5

    def block(args):
        n, q_blk = args
        start = n * BLOCK
        k_blk = lax.dynamic_slice_in_dim(kp, start, 3 * BLOCK, axis=1)
        v_blk = lax.dynamic_slice_in_dim(vp, start, 3 * BLOCK, axis=1)
        s = jnp.einsum('bqhgd,bkhd->bhgqk', q_blk, k_blk).astype(jnp.float32) * scale
        qi = start + jnp.arange(BLOCK)
        kj = start - BLOCK + jnp.arange(3 * BLOCK)
        valid = (jnp.abs(qi[:, None] - kj[None, :]) <= WINDOW) & (kj >= 0)[None, :] & (kj < S)[None, :]
        s = jnp.where(valid, s, NEG)
        m = jnp.maximum(jnp.max(s, axis=-1, keepdims=True), sink_f)
        e = jnp.exp(s - m)
        denom = jnp.sum(e, axis=-1, keepdims=True) + jnp.exp(sink_f - m)
        p = (e / denom).astype(v_blk.dtype)
        return jnp.einsum('bhgqk,bkhd->bqhgd', p, v_blk)

    o = lax.map(block, (jnp.arange(nb), qb))
    o = jnp.moveaxis(o, 0, 1).reshape(B, S, nq)
    return o @ w_o


def diff_attention(h, w_qkv, q_g, k_g, lq1, lk1, lq2, lk2, subln_g, w_o, cos, sin, lambda_init):
    B, S, _ = h.shape
    nqk = DIFF_HEADS * 2 * HEAD_DIM
    qkv = h @ w_qkv
    q = qkv[..., :nqk].reshape(B, S, DIFF_HEADS, 2, HEAD_DIM)
    k = qkv[..., nqk:2 * nqk].reshape(B, S, DIFF_HEADS, 2, HEAD_DIM)
    v = qkv[..., 2 * nqk:].reshape(B, S, DIFF_HEADS, 2 * HEAD_DIM)
    q = apply_rope(rms_norm(q, q_g), cos, sin)
    k = apply_rope(rms_norm(k, k_g), cos, sin)
    f32 = jnp.float32
    lam = (jnp.exp(jnp.sum(lq1.astype(f32) * lk1.astype(f32)))
           - jnp.exp(jnp.sum(lq2.astype(f32) * lk2.astype(f32))) + lambda_init)
    nb = S // BLOCK
    qb = jnp.moveaxis(q.reshape(B, nb, BLOCK, DIFF_HEADS, 2, HEAD_DIM), 1, 0)
    scale = HEAD_DIM ** -0.5

    def block(q_blk):
        s = jnp.einsum('bqhcd,bkhcd->bhcqk', q_blk, k).astype(f32) * scale
        p = jax.nn.softmax(s, axis=-1)
        a = (p[:, :, 0] - lam * p[:, :, 1]).astype(v.dtype)
        return jnp.einsum('bhqk,bkhe->bqhe', a, v)

    o = lax.map(block, qb)
    o = jnp.moveaxis(o, 0, 1).reshape(B, S, DIFF_HEADS, 2 * HEAD_DIM)
    o = rms_norm(o, subln_g) * (1.0 - lambda_init)
    return o.reshape(B, S, D_DIFF) @ w_o


def conv_glu_ffn(h, w_gate, w_up, conv_w, conv_b, w_down):
    g = h @ w_gate
    u = h @ w_up
    gp = jnp.pad(g, ((0, 0), (1, 1), (0, 0)))
    g = gp[:, :-2] * conv_w[0] + gp[:, 1:-1] * conv_w[1] + gp[:, 2:] * conv_w[2] + conv_b
    return (jax.nn.silu(g) * u) @ w_down


def _trunk(x, c, p):
    S = x.shape[1]
    cos, sin = rope_tables(S)
    c_act = jax.nn.silu(c)
    for i in range(DEPTH):
        mod = c_act @ p["ada_w"][i] + p["ada_b"][i]
        sh1, sc1, g1, sh2, sc2, g2 = jnp.split(mod[:, None, :], 6, axis=-1)
        h = rms_norm(x, p["norm1_g"][i]) * (1 + sc1) + sh1
        kind, j = i % N_MIXERS, i // N_MIXERS
        if kind == 0:
            y = fourier_mixer(h, p["fnet_w"][j], p["fnet_b"][j])
        elif kind == 1:
            y = windowed_gqa(h, p["swa_w_qkv"][j], p["swa_q_g"][j], p["swa_k_g"][j],
                             p["swa_sink"][j], p["swa_w_o"][j], cos, sin)
        else:
            lambda_init = 0.8 - 0.6 * math.exp(-0.3 * i)
            y = diff_attention(h, p["diff_w_qkv"][j], p["diff_q_g"][j], p["diff_k_g"][j],
                               p["diff_lq1"][j], p["diff_lk1"][j], p["diff_lq2"][j], p["diff_lk2"][j],
                               p["diff_subln_g"][j], p["diff_w_o"][j], cos, sin, lambda_init)
        x = x + g1 * y
        h = rms_norm(x, p["norm2_g"][i]) * (1 + sc2) + sh2
        x = x + g2 * conv_glu_ffn(h, p["ffn_w_gate"][i], p["ffn_w_up"][i], p["ffn_conv_w"][i],
                                  p["ffn_conv_b"][i], p["ffn_w_down"][i])
    return x


def setup_inputs(seed: int = 0) -> dict:
    key = jax.random.key(seed)
    ks = jax.random.split(key, 40)
    cnt = [0]

    def nrm(shape, scale):
        k = ks[cnt[0]]
        cnt[0] += 1
        return jax.random.normal(k, shape, jnp.float32) * scale

    D = D_MODEL
    qkv_swa = (SWA_Q_HEADS + 2 * SWA_KV_HEADS) * HEAD_DIM
    qkv_diff = 3 * D_DIFF
    nq = SWA_Q_HEADS * HEAD_DIM
    return {
        "x_prompt": nrm((BATCH, SEQ, D), 1.0),
        "x_sample": nrm((DEC_BATCH, DEC_SEQ, D), 1.0),
        "c_prompt": nrm((BATCH, D), 1.0),
        "c_sample": nrm((DEC_BATCH, D), 1.0),
        "ada_w": nrm((DEPTH, D, 6 * D), 0.5 * D ** -0.5),
        "ada_b": nrm((DEPTH, 6 * D), 0.02),
        "norm1_g": 1.0 + nrm((DEPTH, D), 0.02),
        "norm2_g": 1.0 + nrm((DEPTH, D), 0.02),
        "fnet_w": nrm((N_A, D, D), D ** -0.5),
        "fnet_b": nrm((N_A, D), 0.02),
        "swa_w_qkv": nrm((N_B, D, qkv_swa), D ** -0.5),
        "swa_q_g": 1.0 + nrm((N_B, HEAD_DIM), 0.02),
        "swa_k_g": 1.0 + nrm((N_B, HEAD_DIM), 0.02),
        "swa_sink": nrm((N_B, SWA_Q_HEADS), 0.5),
        "swa_w_o": nrm((N_B, nq, D), nq ** -0.5),
        "diff_w_qkv": nrm((N_C, D, qkv_diff), D ** -0.5),
        "diff_q_g": 1.0 + nrm((N_C, HEAD_DIM), 0.02),
        "diff_k_g": 1.0 + nrm((N_C, HEAD_DIM), 0.02),
        "diff_lq1": nrm((N_C, HEAD_DIM), 0.1),
        "diff_lk1": nrm((N_C, HEAD_DIM), 0.1),
        "diff_lq2": nrm((N_C, HEAD_DIM), 0.1),
        "diff_lk2": nrm((N_C, HEAD_DIM), 0.1),
        "diff_subln_g": 1.0 + nrm((N_C, 2 * HEAD_DIM), 0.02),
        "diff_w_o": nrm((N_C, D_DIFF, D), D_DIFF ** -0.5),
        "ffn_w_gate": nrm((DEPTH, D, D_FF), D ** -0.5),
        "ffn_w_up": nrm((DEPTH, D, D_FF), D ** -0.5),
        "ffn_conv_w": nrm((DEPTH, CONV_WIDTH, D_FF), CONV_WIDTH ** -0.5),
        "ffn_conv_b": nrm((DEPTH, D_FF), 0.02),
        "ffn_w_down": nrm((DEPTH, D_FF, D), D_FF ** -0.5),
    }


def reference(x_prompt, x_sample, c_prompt, c_sample, ada_w, ada_b, norm1_g, norm2_g,
              fnet_w, fnet_b, swa_w_qkv, swa_q_g, swa_k_g, swa_sink, swa_w_o,
              diff_w_qkv, diff_q_g, diff_k_g, diff_lq1, diff_lk1, diff_lq2, diff_lk2,
              diff_subln_g, diff_w_o, ffn_w_gate, ffn_w_up, ffn_conv_w, ffn_conv_b, ffn_w_down):
    p = {
        "ada_w": ada_w, "ada_b": ada_b, "norm1_g": norm1_g, "norm2_g": norm2_g,
        "fnet_w": fnet_w, "fnet_b": fnet_b,
        "swa_w_qkv": swa_w_qkv, "swa_q_g": swa_q_g, "swa_k_g": swa_k_g,
        "swa_sink": swa_sink, "swa_w_o": swa_w_o,
        "diff_w_qkv": diff_w_qkv, "diff_q_g": diff_q_g, "diff_k_g": diff_k_g,
        "diff_lq1": diff_lq1, "diff_lk1": diff_lk1, "diff_lq2": diff_lq2, "diff_lk2": diff_lk2,
        "diff_subln_g": diff_subln_g, "diff_w_o": diff_w_o,
        "ffn_w_gate": ffn_w_gate, "ffn_w_up": ffn_w_up, "ffn_conv_w": ffn_conv_w,
        "ffn_conv_b": ffn_conv_b, "ffn_w_down": ffn_w_down,
    }
    y_prompt = _trunk(x_prompt, c_prompt, p)
    y_sample = _trunk(x_sample, c_sample, p)
    return (y_prompt, y_sample)
```

```cpp
#include <hip/hip_runtime.h>
#include <hip/hip_cooperative_groups.h>
#include <cstdio>
#include <cstdint>
#include <cmath>
namespace cg = cooperative_groups;

#define LAS __attribute__((address_space(3)))
typedef unsigned short bf16_t;
typedef short bf16x8 __attribute__((ext_vector_type(8)));
typedef short s16x4 __attribute__((ext_vector_type(4)));
typedef float f32x4 __attribute__((ext_vector_type(4)));
typedef float f32x2 __attribute__((ext_vector_type(2)));
typedef float f32x16 __attribute__((ext_vector_type(16)));
typedef unsigned u32x4 __attribute__((ext_vector_type(4)));
typedef unsigned u32x2 __attribute__((ext_vector_type(2)));

constexpr int T = 98304, TP = 32768, SP = 16384, SS = 2048, DM = 1024, FF = 2816, NSEQ = 34;
constexpr float EPS = 1e-6f;
constexpr float LOG2E = 1.4426950408889634f;
constexpr size_t MiB = 1u << 20;
constexpr size_t WS_DC = 1 * MiB, WS_D1 = WS_DC + 262144, WS_D2 = WS_D1 + 131072, WS_TWP = WS_D2 + 131072, WS_TWS = WS_TWP + 131072;
constexpr size_t WS_ROPE = 2 * MiB, WS_MOD = 6 * MiB;
constexpr size_t WS_FNET = 10 * MiB, WS_SWAQKV = 14 * MiB, WS_SWAWO = 17 * MiB, WS_DIFFQKV = 19 * MiB, WS_DIFFWO = 25 * MiB;
constexpr size_t WS_GU = 27 * MiB, GU_STRIDE = (size_t)5632 * 1024 * 2, WS_DOWN = 71 * MiB, DOWN_STRIDE = (size_t)1024 * 2816 * 2;
constexpr size_t WS_HALO = 96 * MiB, WS_H = 130 * MiB, WS_BIG = 322 * MiB, WS_VT = 706 * MiB, WS_END = 898 * MiB;
static_assert(WS_GU + 4 * GU_STRIDE <= WS_DOWN && WS_DOWN + 4 * DOWN_STRIDE <= WS_HALO, "ws map");
static_assert(WS_HALO + (size_t)3072 * 2816 * 4 <= WS_H && WS_H + (size_t)T * 1024 * 2 <= WS_BIG && WS_BIG + (size_t)T * 2048 * 2 <= WS_VT, "ws map");
static_assert(WS_BIG + (size_t)T * FF * 2 <= WS_END && WS_VT + (size_t)T * 1024 * 2 <= WS_END, "ws map");
constexpr int LDS_BYTES = 147456;

__device__ __forceinline__ unsigned cvt_pk_bf16(float lo, float hi) { unsigned r; asm volatile("v_cvt_pk_bf16_f32 %0, %1, %2" : "=v"(r) : "v"(lo), "v"(hi)); return r; }
__device__ __forceinline__ float bf2f(unsigned short b) { return __uint_as_float(((unsigned)b) << 16); }
__device__ __forceinline__ unsigned short f2bf(float f) { return (unsigned short)(cvt_pk_bf16(f, 0.f) & 0xffffu); }
__device__ __forceinline__ int seq_of(int row) { return row < TP ? (row >> 14) : 2 + ((row - TP) >> 11); }
__device__ __forceinline__ int pos_of(int row) { return row < TP ? (row & (SP - 1)) : ((row - TP) & (SS - 1)); }
__device__ __forceinline__ float wave_sum(float v) {
#pragma unroll
    for (int o = 1; o < 64; o <<= 1) v += __shfl_xor(v, o);
    return v;
}

namespace pg8 {
constexpr int BM = 256, BK = 64, HALF = 128, HTB = HALF * BK * 2, STAGE_BYTES = 8 * HTB;
__host__ __device__ __forceinline__ int lds_byte(int r, int c) { const int st = (r >> 4) * 2 + (c >> 5), rr = r & 15, cc = c & 31, ob = rr * 64 + cc * 2; return st * 1024 + (ob ^ (((ob >> 9) & 1) << 5)); }
__host__ __device__ __forceinline__ void stage_rc(int b, int& R, int& C) { const int st = b / 1024, sb = b % 1024, swz = sb ^ (((sb >> 9) & 1) << 5); R = (st >> 1) * 16 + swz / 64; C = (st & 1) * 32 + (swz % 64) / 2; }
__host__ __device__ __forceinline__ int perm32(int rho) { const int n = rho >> 4, i = rho & 15; return 8 * (i >> 2) + 4 * n + (i & 3); }
struct Unit { int pm, pn, z; };
__device__ __forceinline__ void tile_of(int L, int nM, int nN, int& pm, int& pn) {
    const int nwg = nM * nN; int wgid = L;
    { const int q = nwg / 8, r = nwg % 8, xcd = wgid % 8, off = wgid / 8; wgid = (xcd < r ? xcd * (q + 1) : r * (q + 1) + (xcd - r) * q) + off; }
    const int nig = 8 * nN, gid = wgid / nig, fm = gid * 8, gsz = (nM - fm) < 8 ? (nM - fm) : 8;
    pm = fm + ((wgid % nig) % gsz); pn = (wgid % nig) / gsz;
}
template <class P>
__device__ __forceinline__ void gemm_phase(LAS unsigned char* lds, const P& p) {
    int tid = threadIdx.x; asm volatile("" : "+v"(tid));
    const int wid = __builtin_amdgcn_readfirstlane(tid >> 6), lane = tid & 63, wr = wid >> 2, wc = wid & 3, fr = lane & 15, fq = lane >> 4;
    const int K = p.K, nt = K / BK;
    unsigned voffA[2], voffB[2];
#pragma unroll
    for (int i = 0; i < 2; ++i) { int R, C; stage_rc(tid * 16 + i * 8192, R, C); const int Rb = (R & ~31) + perm32(R & 31);
        voffA[i] = p.a_rowoff(R) + (unsigned)C * 2u; voffB[i] = p.b_rowoff(Rb) + (unsigned)C * 2u; }
    const size_t kstep = (size_t)(BK * 2);
    const size_t hstepA = p.a_hstep(), hstepB = p.b_hstep();
    const unsigned ldsw = (unsigned)wid * 1024u;
    const int aoff = lds_byte(wr * 64 + fr, fq * 8), boff = lds_byte(wc * 32 + fr, fq * 8);
#define PG8_SA(b, h) (((b) * 2 + (h)) * HTB)
#define PG8_SB(b, h) ((4 + (b) * 2 + (h)) * HTB)
#define PG8_STAGE(bufoff, gbase, voff) do { _Pragma("unroll") for (int _i = 0; _i < 2; ++_i) \
        __builtin_amdgcn_global_load_lds((const unsigned*)((const char*)(gbase) + (voff)[_i]), (LAS unsigned*)(lds + (bufoff) + ldsw + _i * 8192), 16, 0, 0); } while (0)
#define PG8_LDA(dst, b, h) do { _Pragma("unroll") for (int m = 0; m < 4; ++m) _Pragma("unroll") for (int k = 0; k < 2; ++k) dst[m][k] = *(const LAS bf16x8*)(lds + PG8_SA(b, h) + aoff + m * 2048 + k * 1024); } while (0)
#define PG8_LDB(dst, b, h) do { _Pragma("unroll") for (int n = 0; n < 2; ++n) _Pragma("unroll") for (int k = 0; k < 2; ++k) dst[n][k] = *(const LAS bf16x8*)(lds + PG8_SB(b, h) + boff + n * 2048 + k * 1024); } while (0)
#define PG8_MMA(ai, bj, At, Bt) do { __builtin_amdgcn_s_setprio(1); _Pragma("unroll") for (int m = 0; m < 4; ++m) _Pragma("unroll") for (int n = 0; n < 2; ++n) _Pragma("unroll") for (int k = 0; k < 2; ++k) \
        acc[ai][bj][m][n] = __builtin_amdgcn_mfma_f32_16x16x32_bf16(Bt[n][k], At[m][k], acc[ai][bj][m][n], 0, 0, 0); __builtin_amdgcn_s_setprio(0); } while (0)
#define PG8_WAIT_V(n) asm volatile("s_waitcnt vmcnt(" #n ")" ::: "memory")
#define PG8_WAIT_L(n) asm volatile("s_waitcnt lgkmcnt(" #n ")" ::: "memory")
#define PG8_BAR __builtin_amdgcn_s_barrier()
#define PG8_SCHED __builtin_amdgcn_sched_barrier(0)
    Unit cur, nxt; int ui = 0;
    if (!p.next(0, cur)) return;
    f32x4 acc[2][2][4][2];
#pragma unroll
    for (int a = 0; a < 2; ++a)
#pragma unroll
        for (int b = 0; b < 2; ++b)
#pragma unroll
            for (int m = 0; m < 4; ++m)
#pragma unroll
                for (int n = 0; n < 2; ++n) acc[a][b][m][n] = (f32x4){0.f, 0.f, 0.f, 0.f};
    bf16x8 At[4][2], B0[2][2], B1[2][2];
    const char* cA = p.a_base(cur); const char* cB = p.b_base(cur);
    PG8_STAGE(PG8_SB(0, 0), cB, voffB); PG8_STAGE(PG8_SB(0, 1), cB + hstepB, voffB); PG8_STAGE(PG8_SA(0, 0), cA, voffA); PG8_STAGE(PG8_SA(0, 1), cA + hstepA, voffA);
    if (wr == 1) PG8_BAR;
    PG8_WAIT_V(2); PG8_BAR;
    PG8_STAGE(PG8_SB(1, 0), cB + kstep, voffB); PG8_STAGE(PG8_SA(1, 0), cA + kstep, voffA); PG8_STAGE(PG8_SB(1, 1), cB + hstepB + kstep, voffB);
    PG8_WAIT_V(6); PG8_BAR;
    for (;;) {
        const bool has_next = p.next(ui + 1, nxt);
        const char* nA = has_next ? p.a_base(nxt) : cA; const char* nB = has_next ? p.b_base(nxt) : cB;
        for (int t = 0; t < nt; t += 2) {
            const bool last = (t == nt - 2);
            const char* a1 = cA + (size_t)(t + 1) * kstep;
            const char* a2 = last ? nA : cA + (size_t)(t + 2) * kstep; const char* b2 = last ? nB : cB + (size_t)(t + 2) * kstep;
            const char* a3 = a2 + kstep; const char* b3 = b2 + kstep;
            PG8_LDB(B0, 0, 0); PG8_LDB(B1, 0, 1); PG8_SCHED; PG8_LDA(At, 0, 0); PG8_STAGE(PG8_SA(1, 1), a1 + hstepA, voffA);
            PG8_WAIT_V(8); PG8_WAIT_L(0); PG8_BAR; PG8_MMA(0, 0, At, B0); PG8_MMA(0, 1, At, B1); PG8_BAR; PG8_SCHED;
            PG8_LDA(At, 0, 1); PG8_STAGE(PG8_SB(0, 0), b2, voffB); PG8_STAGE(PG8_SB(0, 1), b2 + hstepB, voffB); PG8_STAGE(PG8_SA(0, 0), a2, voffA);
            PG8_WAIT_V(8); PG8_WAIT_L(0); PG8_BAR; PG8_MMA(1, 0, At, B0); PG8_MMA(1, 1, At, B1); PG8_BAR; PG8_SCHED;
            PG8_LDB(B0, 1, 0); PG8_LDB(B1, 1, 1); PG8_SCHED; PG8_LDA(At, 1, 0); PG8_STAGE(PG8_SA(0, 1), a2 + hstepA, voffA);
            PG8_WAIT_V(8); PG8_WAIT_L(0); PG8_BAR; PG8_MMA(0, 0, At, B0); PG8_MMA(0, 1, At, B1); PG8_BAR; PG8_SCHED;
            PG8_LDA(At, 1, 1); PG8_STAGE(PG8_SB(1, 0), b3, voffB); PG8_STAGE(PG8_SB(1, 1), b3 + hstepB, voffB); PG8_STAGE(PG8_SA(1, 0), a3, voffA);
            PG8_WAIT_V(8); PG8_WAIT_L(0); PG8_BAR; PG8_MMA(1, 0, At, B0); PG8_MMA(1, 1, At, B1); PG8_BAR; PG8_SCHED;
        }
        if (wr == 0) PG8_BAR;
        { int fr_ = fr, fq_ = fq; asm volatile("" : "+v"(fr_), "+v"(fq_)); p.epi(acc, cur, wr, wc, fr_, fq_); }
        if (!has_next) break;
#pragma unroll
        for (int a = 0; a < 2; ++a)
#pragma unroll
            for (int b = 0; b < 2; ++b)
#pragma unroll
                for (int m = 0; m < 4; ++m)
#pragma unroll
                    for (int n = 0; n < 2; ++n) acc[a][b][m][n] = (f32x4){0.f, 0.f, 0.f, 0.f};
        cur = nxt; cA = nA; cB = nB; ++ui;
        if (wr == 1) PG8_BAR;
    }
    PG8_WAIT_V(0);
    PG8_BAR;
#undef PG8_SA
#undef PG8_SB
#undef PG8_STAGE
#undef PG8_LDA
#undef PG8_LDB
#undef PG8_MMA
#undef PG8_WAIT_V
#undef PG8_WAIT_L
#undef PG8_BAR
#undef PG8_SCHED
}
typedef f32x4 Acc[2][2][4][2];
__device__ __forceinline__ void store_tile_bf16(Acc& acc, bf16_t* base, size_t ldc, int wr, int wc, int fr, int fq) {
#pragma unroll
    for (int ai = 0; ai < 2; ++ai)
#pragma unroll
        for (int m = 0; m < 4; ++m) { bf16_t* rowp = base + (size_t)(ai * HALF + wr * 64 + m * 16 + fr) * ldc + wc * 32 + 8 * fq;
#pragma unroll
            for (int bj = 0; bj < 2; ++bj) { const f32x4 v0 = acc[ai][bj][m][0], v1 = acc[ai][bj][m][1]; u32x4 w;
                w.x = cvt_pk_bf16(v0[0], v0[1]); w.y = cvt_pk_bf16(v0[2], v0[3]); w.z = cvt_pk_bf16(v1[0], v1[1]); w.w = cvt_pk_bf16(v1[2], v1[3]);
                *(u32x4*)(rowp + bj * HALF) = w; } }
}
}
using pg8::Unit; using pg8::Acc; using pg8::tile_of;

struct ProbQKV {
    int K; const char* H; const char* W; int nqk, nv; bf16_t* QKout; int ldq; bf16_t* VTout; int G, c;
    __device__ __forceinline__ unsigned a_rowoff(int R) const { return (unsigned)R * 2048u; }
    __device__ __forceinline__ unsigned b_rowoff(int R) const { return (unsigned)R * 2048u; }
    __device__ __forceinline__ size_t a_hstep() const { return (size_t)128 * 2048; }
    __device__ __forceinline__ size_t b_hstep() const { return (size_t)128 * 2048; }
    __device__ __forceinline__ bool next(int i, Unit& u) const { long L = (long)i * G + c; const int n0 = 384 * nqk, n1 = 384 * nv;
        if (L < n0) { u.z = 0; tile_of((int)L, 384, nqk, u.pm, u.pn); return true; } L -= n0;
        if (L < n1) { u.z = 1; tile_of((int)L, nv, 384, u.pm, u.pn); return true; } return false; }
    __device__ __forceinline__ const char* a_base(const Unit& u) const { return u.z == 0 ? H + (size_t)u.pm * 256 * 2048 : W + (size_t)(nqk * 256 + u.pm * 256) * 2048; }
    __device__ __forceinline__ const char* b_base(const Unit& u) const { return u.z == 0 ? W + (size_t)u.pn * 256 * 2048 : H + (size_t)u.pn * 256 * 2048; }
    __device__ __forceinline__ void epi(Acc& acc, const Unit& u, int wr, int wc, int fr, int fq) const {
        bf16_t* base; size_t ldc;
        if (u.z == 0) { ldc = (size_t)ldq; base = QKout + (size_t)u.pm * 256 * ldc + u.pn * 256; } else { ldc = (size_t)T; base = VTout + (size_t)u.pm * 256 * ldc + u.pn * 256; }
        pg8::store_tile_bf16(acc, base, ldc, wr, wc, fr, fq);
    }
};
struct ProbResid {
    int K; const char* A; unsigned a_pitch; const char* W; const float* xin0; const float* xin1; float* out; const float* gate; const float* bias; int G, c;
    __device__ __forceinline__ unsigned a_rowoff(int R) const { return (unsigned)R * a_pitch; }
    __device__ __forceinline__ unsigned b_rowoff(int R) const { return (unsigned)R * (unsigned)(K * 2); }
    __device__ __forceinline__ size_t a_hstep() const { return (size_t)128 * a_pitch; }
    __device__ __forceinline__ size_t b_hstep() const { return (size_t)128 * K * 2; }
    __device__ __forceinline__ bool next(int i, Unit& u) const { const long L = (long)i * G + c; if (L >= 1536) return false; u.z = 0; tile_of((int)L, 384, 4, u.pm, u.pn); return true; }
    __device__ __forceinline__ const char* a_base(const Unit& u) const { return A + (size_t)u.pm * 256 * a_pitch; }
    __device__ __forceinline__ const char* b_base(const Unit& u) const { return W + (size_t)u.pn * 256 * K * 2; }
    __device__ __forceinline__ void epi(Acc& acc, const Unit& u, int wr, int wc, int fr, int fq) const {
        const int row0 = u.pm * 256; const float* gp = gate + (size_t)seq_of(row0) * 6144;
#pragma unroll
        for (int bj = 0; bj < 2; ++bj) { const int col = u.pn * 256 + bj * 128 + wc * 32 + 8 * fq;
            const f32x4 g0 = *(const f32x4*)(gp + col), g1 = *(const f32x4*)(gp + col + 4);
            f32x4 b0 = (f32x4){0.f, 0.f, 0.f, 0.f}, b1 = b0; if (bias) { b0 = *(const f32x4*)(bias + col); b1 = *(const f32x4*)(bias + col + 4); }
#pragma unroll
            for (int ai = 0; ai < 2; ++ai)
#pragma unroll
                for (int m = 0; m < 4; ++m) { const int row = row0 + ai * 128 + wr * 64 + m * 16 + fr;
                    const float* xs = (row < TP ? xin0 + (size_t)row * 1024 : xin1 + (size_t)(row - TP) * 1024) + col;
                    const f32x4 x0 = *(const f32x4*)xs, x1 = *(const f32x4*)(xs + 4);
                    float* op = out + (size_t)row * 1024 + col;
                    *(f32x4*)op = x0 + g0 * (acc[ai][bj][m][0] + b0); *(f32x4*)(op + 4) = x1 + g1 * (acc[ai][bj][m][1] + b1); } }
    }
};
struct ProbHalo {
    int K; const char* H; const char* W; float* Gh; int G, c;
    __device__ __forceinline__ unsigned a_rowoff(int R) const { return (unsigned)(64 * (R >> 1) + 63 * (R & 1)) * 2048u; }
    __device__ __forceinline__ unsigned b_rowoff(int R) const { return (unsigned)R * 2048u; }
    __device__ __forceinline__ size_t a_hstep() const { return (size_t)4096 * 2048; }
    __device__ __forceinline__ size_t b_hstep() const { return (size_t)256 * 2048; }
    __device__ __forceinline__ bool next(int i, Unit& u) const { const long L = (long)i * G + c; if (L >= 132) return false; u.z = 0; u.pm = (int)(L % 12); u.pn = (int)(L / 12); return true; }
    __device__ __forceinline__ const char* a_base(const Unit& u) const { return H + (size_t)u.pm * 8192 * 2048; }
    __device__ __forceinline__ const char* b_base(const Unit& u) const { return W + (size_t)u.pn * 512 * 2048; }
    __device__ __forceinline__ void epi(Acc& acc, const Unit& u, int wr, int wc, int fr, int fq) const {
#pragma unroll
        for (int ai = 0; ai < 2; ++ai)
#pragma unroll
            for (int m = 0; m < 4; ++m) { float* rp = Gh + (size_t)(u.pm * 256 + ai * 128 + wr * 64 + m * 16 + fr) * FF + u.pn * 256 + wc * 32 + 8 * fq;
#pragma unroll
                for (int bj = 0; bj < 2; ++bj) { *(f32x4*)(rp + bj * 128) = acc[ai][bj][m][0]; *(f32x4*)(rp + bj * 128 + 4) = acc[ai][bj][m][1]; } }
    }
};
struct ProbGateUp {
    int K; const char* H; const char* W; const float* Gh; const float* cw; const float* cb; bf16_t* act; int G, c;
    __device__ __forceinline__ unsigned a_rowoff(int R) const { return (unsigned)R * 2048u; }
    __device__ __forceinline__ unsigned b_rowoff(int R) const { return (unsigned)R * 2048u; }
    __device__ __forceinline__ size_t a_hstep() const { return (size_t)128 * 2048; }
    __device__ __forceinline__ size_t b_hstep() const { return (size_t)128 * 2048; }
    __device__ __forceinline__ bool next(int i, Unit& u) const { const long L = (long)i * G + c; if (L >= 384 * 22) return false; u.z = 0; tile_of((int)L, 384, 22, u.pm, u.pn); return true; }
    __device__ __forceinline__ const char* a_base(const Unit& u) const { return H + (size_t)u.pm * 256 * 2048; }
    __device__ __forceinline__ const char* b_base(const Unit& u) const { return W + (size_t)u.pn * 256 * 2048; }
    __device__ __forceinline__ void epi(Acc& acc, const Unit& u, int wr, int wc, int fr, int fq) const {
        const int lane = threadIdx.x & 63;
        const int colb = u.pn * 128 + wc * 32 + 8 * fq;
        float w0[8], w1[8], w2[8], bb[8];
#pragma unroll
        for (int q = 0; q < 2; ++q) { const f32x4 a = *(const f32x4*)(cw + colb + 4 * q), b = *(const f32x4*)(cw + FF + colb + 4 * q), cc = *(const f32x4*)(cw + 2 * FF + colb + 4 * q), d = *(const f32x4*)(cb + colb + 4 * q);
#pragma unroll
            for (int j = 0; j < 4; ++j) { w0[4 * q + j] = a[j]; w1[4 * q + j] = b[j]; w2[4 * q + j] = cc[j]; bb[4 * q + j] = d[j]; } }
        const int src_up = (fr == 0) ? lane + 15 : lane - 1, src_dn = (fr == 15) ? lane - 15 : lane + 1;
#pragma unroll
        for (int ai = 0; ai < 2; ++ai) {
            const int blk = u.pm * 4 + ai * 2 + wr;
            const bool first = blk < 512 ? ((blk & 255) == 0) : (((blk - 512) & 31) == 0);
            const bool lastb = blk < 512 ? ((blk & 255) == 255) : (((blk - 512) & 31) == 31);
            float hp[8], hn[8];
#pragma unroll
            for (int q = 0; q < 2; ++q) { f32x4 a = (f32x4){0.f, 0.f, 0.f, 0.f}, b = a;
                if (!first) a = *(const f32x4*)(Gh + (size_t)(2 * (blk - 1) + 1) * FF + colb + 4 * q);
                if (!lastb) b = *(const f32x4*)(Gh + (size_t)(2 * (blk + 1)) * FF + colb + 4 * q);
#pragma unroll
                for (int j = 0; j < 4; ++j) { hp[4 * q + j] = a[j]; hn[4 * q + j] = b[j]; } }
#pragma unroll
            for (int n = 0; n < 2; ++n)
#pragma unroll
                for (int j = 0; j < 4; ++j) { const int cidx = 4 * n + j; float rup[4], rdn[4];
#pragma unroll
                    for (int m = 0; m < 4; ++m) { const float gv = acc[ai][0][m][n][j]; rup[m] = __shfl(gv, src_up); rdn[m] = __shfl(gv, src_dn); }
#pragma unroll
                    for (int m = 0; m < 4; ++m) {
                        const float prev = (fr == 0) ? (m == 0 ? hp[cidx] : rup[m == 0 ? 0 : m - 1]) : rup[m];
                        const float nextv = (fr == 15) ? (m == 3 ? hn[cidx] : rdn[m == 3 ? 3 : m + 1]) : rdn[m];
                        const float cv = w0[cidx] * prev + w1[cidx] * acc[ai][0][m][n][j] + w2[cidx] * nextv + bb[cidx];
                        const float sg = __builtin_amdgcn_rcpf(1.0f + __expf(-cv));
                        acc[ai][0][m][n][j] = cv * sg * acc[ai][1][m][n][j]; } }
#pragma unroll
            for (int m = 0; m < 4; ++m) { const int row = u.pm * 256 + ai * 128 + wr * 64 + m * 16 + fr; const f32x4 v0 = acc[ai][0][m][0], v1 = acc[ai][0][m][1]; u32x4 w;
                w.x = cvt_pk_bf16(v0[0], v0[1]); w.y = cvt_pk_bf16(v0[2], v0[3]); w.z = cvt_pk_bf16(v1[0], v1[1]); w.w = cvt_pk_bf16(v1[2], v1[3]);
                *(u32x4*)(act + (size_t)row * FF + colb) = w; }
        }
    }
};
struct ProbF0 {
    int K; const char* Dc; const char* H; bf16_t* ZT; int part; int G, c;
    __device__ __forceinline__ unsigned a_rowoff(int R) const { return (unsigned)R * 512u; }
    __device__ __forceinline__ unsigned b_rowoff(int R) const { return (unsigned)R * (part == 0 ? 128u * 2048u : 16u * 2048u); }
    __device__ __forceinline__ size_t a_hstep() const { return (size_t)128 * 512; }
    __device__ __forceinline__ size_t b_hstep() const { return (size_t)2048; }
    __device__ __forceinline__ bool next(int i, Unit& u) const { const long L = (long)i * G + c; const int nct = part == 0 ? 128 : 256; if (L >= 8 * nct) return false;
        u.pn = (int)(L / 8); u.pm = (int)(L & 1); u.z = (int)((L >> 1) & 3); return true; }
    __device__ __forceinline__ const char* a_base(const Unit& u) const { return Dc + (size_t)u.pm * 256 * 512; }
    __device__ __forceinline__ const char* b_base(const Unit& u) const {
        const int ct = u.pn; const int tok = part == 0 ? (ct >> 6) * SP + 2 * (ct & 63) : TP + (ct >> 3) * SS + 2 * (ct & 7);
        return H + (size_t)tok * 2048 + u.z * 512; }
    __device__ __forceinline__ void epi(Acc& acc, const Unit& u, int wr, int wc, int fr, int fq) const {
        const int jb0 = (part == 0 ? 0 : 256) + 2 * u.pn;
#pragma unroll
        for (int ai = 0; ai < 2; ++ai)
#pragma unroll
            for (int m = 0; m < 4; ++m) { const int kc = ai * 128 + wr * 64 + m * 16 + fr; bf16_t* rp = ZT + (size_t)(u.z * 256 + kc) * (2 * T) + u.pm * 128 + wc * 32 + 8 * fq;
#pragma unroll
                for (int bj = 0; bj < 2; ++bj) { const f32x4 v0 = acc[ai][bj][m][0], v1 = acc[ai][bj][m][1]; u32x4 w;
                    w.x = cvt_pk_bf16(v0[0], v0[1]); w.y = cvt_pk_bf16(v0[2], v0[3]); w.z = cvt_pk_bf16(v1[0], v1[1]); w.w = cvt_pk_bf16(v1[2], v1[3]);
                    *(u32x4*)(rp + (size_t)(jb0 + bj) * 256) = w; } }
    }
};
struct ProbF1 {
    int K; const char* D1; bf16_t* ZT; const f32x2* TWp; const f32x2* TWs; int G, c;
    __device__ __forceinline__ unsigned a_rowoff(int R) const { return (unsigned)R * 512u; }
    __device__ __forceinline__ unsigned b_rowoff(int R) const { return (unsigned)R * 512u; }
    __device__ __forceinline__ size_t a_hstep() const { return (size_t)128 * 512; }
    __device__ __forceinline__ size_t b_hstep() const { return (size_t)128 * 512; }
    __device__ __forceinline__ bool next(int i, Unit& u) const { const long L = (long)i * G + c; if (L >= 3072) return false; u.pm = 0; u.pn = (int)(L / 3); u.z = (int)(L % 3); return true; }
    __device__ __forceinline__ const char* a_base(const Unit&) const { return D1; }
    __device__ __forceinline__ const char* b_base(const Unit& u) const { return (const char*)ZT + ((size_t)u.pn * (2 * T) + (size_t)u.z * 65536) * 2; }
    __device__ __forceinline__ void epi(Acc& acc, const Unit& u, int wr, int wc, int fr, int fq) const {
        bf16_t* reg = ZT + (size_t)u.pn * (2 * T) + (size_t)u.z * 65536;
#pragma unroll
        for (int m = 0; m < 4; ++m) { const int k1 = wr * 64 + m * 16 + fr;
#pragma unroll
            for (int bj = 0; bj < 2; ++bj) {
                int n2b; size_t off; const f32x2* tw;
                if (u.z == 0) { n2b = wc * 32 + 8 * fq; tw = TWp + k1 * 128 + n2b; off = (size_t)((k1 * 2 + bj) * 2) * 128 + n2b; }
                else { n2b = 8 * (fq & 1); const int blo = 8 * bj + 2 * wc + (fq >> 1); tw = TWs + k1 * 16 + n2b; off = (size_t)((k1 * 16 + blo) * 2) * 16 + n2b; }
                const int ro_stride = (u.z == 0) ? 128 : 16;
                float re[8], im[8];
#pragma unroll
                for (int n = 0; n < 2; ++n)
#pragma unroll
                    for (int j = 0; j < 4; ++j) { const f32x2 t = tw[4 * n + j]; const float a = acc[0][bj][m][n][j], b = acc[1][bj][m][n][j];
                        re[4 * n + j] = a * t.x + b * t.y; im[4 * n + j] = b * t.x - a * t.y; }
                u32x4 wre, wim;
                wre.x = cvt_pk_bf16(re[0], re[1]); wre.y = cvt_pk_bf16(re[2], re[3]); wre.z = cvt_pk_bf16(re[4], re[5]); wre.w = cvt_pk_bf16(re[6], re[7]);
                wim.x = cvt_pk_bf16(im[0], im[1]); wim.y = cvt_pk_bf16(im[2], im[3]); wim.z = cvt_pk_bf16(im[4], im[5]); wim.w = cvt_pk_bf16(im[6], im[7]);
                *(u32x4*)(reg + off) = wre; *(u32x4*)(reg + off + ro_stride) = wim; asm volatile("" ::: "memory"); } }
    }
};
struct ProbF2p {
    int K; const char* D2; const char* ZT; bf16_t* F; int G, c;
    __device__ __forceinline__ unsigned a_rowoff(int R) const { return (unsigned)R * 512u; }
    __device__ __forceinline__ unsigned b_rowoff(int R) const { return (unsigned)R * (unsigned)(2 * T * 2); }
    __device__ __forceinline__ size_t a_hstep() const { return (size_t)128 * 512; }
    __device__ __forceinline__ size_t b_hstep() const { return (size_t)128 * (2 * T * 2); }
    __device__ __forceinline__ bool next(int i, Unit& u) const { const long L = (long)i * G + c; if (L >= 1024) return false; u.pm = 0; u.pn = (int)(L >> 2); u.z = (int)(L & 3); return true; }
    __device__ __forceinline__ const char* a_base(const Unit&) const { return D2; }
    __device__ __forceinline__ const char* b_base(const Unit& u) const { return ZT + (size_t)u.z * 256 * (2 * T * 2) + (size_t)u.pn * 512; }
    __device__ __forceinline__ void epi(Acc& acc, const Unit& u, int wr, int wc, int fr, int fq) const {
        const int k1 = u.pn >> 1, b = u.pn & 1;
#pragma unroll
        for (int m = 0; m < 4; ++m) { const int k2 = wr * 64 + m * 16 + fr; bf16_t* rp = F + (size_t)(b * SP + k1 + 128 * k2) * 1024 + u.z * 256 + wc * 32 + 8 * fq;
#pragma unroll
            for (int bj = 0; bj < 2; ++bj) { const f32x4 v0 = acc[0][bj][m][0], v1 = acc[0][bj][m][1]; u32x4 w;
                w.x = cvt_pk_bf16(v0[0], v0[1]); w.y = cvt_pk_bf16(v0[2], v0[3]); w.z = cvt_pk_bf16(v1[0], v1[1]); w.w = cvt_pk_bf16(v1[2], v1[3]);
                *(u32x4*)(rp + bj * 128) = w; } }
    }
};

__device__ __forceinline__ int crow(int r, int hi) { return (r & 3) + 8 * (r >> 2) + 4 * hi; }
struct AttnArgs {
    const bf16_t* QK; int ldq;
    const bf16_t* VT;
    bf16_t* O;
    int seq0, S, qpos0;
    int qcol0, kcol, vrow0, ocol0;
    int kt_lo, kt_hi;
    float sink2a, sink2b;
    float lam, post;
    const float* subg;
};
template <int MODE>
__device__ __forceinline__ void attn_unit(unsigned char* lds, const AttnArgs& a) {
    constexpr int KW = MODE == 0 ? 64 : 128, DV = MODE == 0 ? 64 : 128, NDB = DV / 32, KPB = (KW + 8) * 2, VPB = 144, NLD = MODE == 0 ? 1 : 2;
    int tid = threadIdx.x; asm volatile("" : "+v"(tid));
    const int lane = tid & 63, r32 = lane & 31, hi = lane >> 5; const int wid = __builtin_amdgcn_readfirstlane(tid >> 6), wg = wid >> 2, wq = wid & 3;
    unsigned char* Ks = lds; unsigned char* Vs = lds + 64 * KPB;
    const int qrow = a.seq0 + a.qpos0 + wq * 32 + r32;
    bf16x8 qr[4];
    { const bf16_t* qp = a.QK + (size_t)qrow * a.ldq + a.qcol0 + wg * 64 + hi * 8;
#pragma unroll
      for (int d0 = 0; d0 < 4; ++d0) qr[d0] = *(const bf16x8*)(qp + d0 * 16); }
    const int coff = MODE == 0 ? 0 : wg * 64;
    f32x16 o[NDB];
#pragma unroll
    for (int i = 0; i < NDB; ++i)
#pragma unroll
        for (int r = 0; r < 16; ++r) o[i][r] = 0.f;
    float mrun = -1e30f, lrun = 0.f;
    u32x4 kreg[NLD], vreg[NLD];
    const int NT = a.kt_hi - a.kt_lo;
    auto prefetch = [&](int kt) {
        const int kp0 = kt * 64;
#pragma unroll
        for (int i = 0; i < NLD; ++i) { const int idx = tid + 512 * i;
            if (MODE == 0) { const int key = idx >> 3, ch = idx & 7; kreg[i] = *(const u32x4*)(a.QK + (size_t)(a.seq0 + kp0 + key) * a.ldq + a.kcol + ch * 8); }
            else { const int key = idx >> 4, ch = idx & 15; kreg[i] = *(const u32x4*)(a.QK + (size_t)(a.seq0 + kp0 + key) * a.ldq + a.kcol + ch * 8); }
            const int d = idx >> 3, ch = idx & 7; vreg[i] = *(const u32x4*)(a.VT + (size_t)(a.vrow0 + d) * T + a.seq0 + kp0 + ch * 8); }
    };
    prefetch(a.kt_lo);
    for (int t = 0; t < NT; ++t) {
        __syncthreads();
#pragma unroll
        for (int i = 0; i < NLD; ++i) { const int idx = tid + 512 * i;
            if (MODE == 0) { const int key = idx >> 3, ch = idx & 7; *(u32x4*)(Ks + key * KPB + ch * 16) = kreg[i]; }
            else { const int key = idx >> 4, ch = idx & 15; *(u32x4*)(Ks + key * KPB + ch * 16) = kreg[i]; }
            const int d = idx >> 3, ch = idx & 7; *(u32x4*)(Vs + d * VPB + ch * 16) = vreg[i]; }
        __syncthreads();
        if (t + 1 < NT) prefetch(a.kt_lo + t + 1);
        const int kp0 = (a.kt_lo + t) * 64;
        f32x16 s[2];
#pragma unroll
        for (int kb = 0; kb < 2; ++kb) {
#pragma unroll
            for (int r = 0; r < 16; ++r) s[kb][r] = 0.f;
#pragma unroll
            for (int d0 = 0; d0 < 4; ++d0) { const bf16x8 kf = *(const bf16x8*)(Ks + (32 * kb + r32) * KPB + (coff + 16 * d0 + 8 * hi) * 2);
                s[kb] = __builtin_amdgcn_mfma_f32_32x32x16_bf16(kf, qr[d0], s[kb], 0, 0, 0); }
        }
        if (MODE == 0) { const int qi = a.qpos0 + wq * 32 + r32;
#pragma unroll
            for (int kb = 0; kb < 2; ++kb)
#pragma unroll
                for (int r = 0; r < 16; ++r) { const int dlt = qi - (kp0 + 32 * kb + crow(r, hi)); if (dlt > 128 || dlt < -128) s[kb][r] = -INFINITY; } }
        float mx = s[0][0];
#pragma unroll
        for (int r = 1; r < 16; ++r) mx = fmaxf(mx, s[0][r]);
#pragma unroll
        for (int r = 0; r < 16; ++r) mx = fmaxf(mx, s[1][r]);
        mx = fmaxf(mx, __shfl_xor(mx, 32));
        const float mnew = fmaxf(mrun, mx), alpha = __builtin_amdgcn_exp2f(mrun - mnew); mrun = mnew;
        float ps = 0.f;
#pragma unroll
        for (int kb = 0; kb < 2; ++kb)
#pragma unroll
            for (int r = 0; r < 16; ++r) { const float pv = __builtin_amdgcn_exp2f(s[kb][r] - mnew); s[kb][r] = pv; ps += pv; }
        lrun = lrun * alpha + ps;
#pragma unroll
        for (int i = 0; i < NDB; ++i)
#pragma unroll
            for (int r = 0; r < 16; ++r) o[i][r] *= alpha;
        bf16x8 pk[2][2];
#pragma unroll
        for (int kb = 0; kb < 2; ++kb)
#pragma unroll
            for (int kg = 0; kg < 2; ++kg) { u32x4 w; w.x = cvt_pk_bf16(s[kb][8 * kg + 0], s[kb][8 * kg + 1]); w.y = cvt_pk_bf16(s[kb][8 * kg + 2], s[kb][8 * kg + 3]);
                w.z = cvt_pk_bf16(s[kb][8 * kg + 4], s[kb][8 * kg + 5]); w.w = cvt_pk_bf16(s[kb][8 * kg + 6], s[kb][8 * kg + 7]); pk[kb][kg] = __builtin_bit_cast(bf16x8, w); }
#pragma unroll
        for (int i = 0; i < NDB; ++i)
#pragma unroll
            for (int kb = 0; kb < 2; ++kb)
#pragma unroll
                for (int kg = 0; kg < 2; ++kg) { const unsigned char* vp = Vs + (32 * i + r32) * VPB + (32 * kb + 16 * kg + 4 * hi) * 2;
                    const s16x4 lo = *(const s16x4*)vp, h4 = *(const s16x4*)(vp + 16);
                    const bf16x8 vf = (bf16x8){lo[0], lo[1], lo[2], lo[3], h4[0], h4[1], h4[2], h4[3]};
                    o[i] = __builtin_amdgcn_mfma_f32_32x32x16_bf16(vf, pk[kb][kg], o[i], 0, 0, 0); }
    }
    const float ltot = lrun + __shfl_xor(lrun, 32);
    if (MODE == 0) {
        const float sk = wg == 0 ? a.sink2a : a.sink2b; const float mf = fmaxf(mrun, sk), al = __builtin_amdgcn_exp2f(mrun - mf);
        const float inv = al / (ltot * al + __builtin_amdgcn_exp2f(sk - mf));
        bf16_t* op = a.O + (size_t)qrow * 1024 + a.ocol0 + wg * 64 + 4 * hi;
#pragma unroll
        for (int i = 0; i < NDB; ++i)
#pragma unroll
            for (int rq = 0; rq < 4; ++rq) { u32x2 w; w.x = cvt_pk_bf16(o[i][4 * rq] * inv, o[i][4 * rq + 1] * inv); w.y = cvt_pk_bf16(o[i][4 * rq + 2] * inv, o[i][4 * rq + 3] * inv);
                *(u32x2*)(op + 32 * i + 8 * rq) = w; }
    } else {
        const float inv = 1.0f / ltot;
        float* X = (float*)lds;
        __syncthreads();
        if (wg == 1) {
#pragma unroll
            for (int i = 0; i < NDB; ++i)
#pragma unroll
                for (int rq = 0; rq < 4; ++rq) *(f32x4*)(X + (wq * 32 + r32) * 132 + 32 * i + 8 * rq + 4 * hi) = (f32x4){o[i][4 * rq] * inv, o[i][4 * rq + 1] * inv, o[i][4 * rq + 2] * inv, o[i][4 * rq + 3] * inv};
        }
        __syncthreads();
        if (wg == 0) {
            float ss = 0.f;
#pragma unroll
            for (int i = 0; i < NDB; ++i)
#pragma unroll
                for (int rq = 0; rq < 4; ++rq) { const f32x4 x1 = *(const f32x4*)(X + (wq * 32 + r32) * 132 + 32 * i + 8 * rq + 4 * hi);
#pragma unroll
                    for (int j = 0; j < 4; ++j) { const float v = o[i][4 * rq + j] * inv - a.lam * x1[j]; o[i][4 * rq + j] = v; ss += v * v; } }
            ss += __shfl_xor(ss, 32);
            const float rs = rsqrtf(ss * (1.0f / 128.0f) + EPS) * a.post;
            bf16_t* op = a.O + (size_t)qrow * 1024 + a.ocol0 + 4 * hi;
#pragma unroll
            for (int i = 0; i < NDB; ++i)
#pragma unroll
                for (int rq = 0; rq < 4; ++rq) { const f32x4 g = *(const f32x4*)(a.subg + 32 * i + 8 * rq + 4 * hi); u32x2 w;
                    w.x = cvt_pk_bf16(o[i][4 * rq] * rs * g[0], o[i][4 * rq + 1] * rs * g[1]); w.y = cvt_pk_bf16(o[i][4 * rq + 2] * rs * g[2], o[i][4 * rq + 3] * rs * g[3]);
                    *(u32x2*)(op + 32 * i + 8 * rq) = w; }
        }
    }
}

__device__ __forceinline__ void transpose_item(const float* W, int K, int N, bf16_t* WT, int mode, float* scr, int item, int lane) {
    const int nblk = N / 32, kb = item / nblk, nb = item % nblk, k0 = 64 * kb, n0 = 32 * nb;
    const int drow = mode == 0 ? n0 : ((n0 >> 7) * 256 + (n0 & 127) + (mode == 2 ? 128 : 0));
#pragma unroll 8
    for (int i = 0; i < 32; ++i) { const int kk = 2 * i + (lane >> 5); scr[kk * 33 + (lane & 31)] = W[(size_t)(k0 + kk) * N + n0 + (lane & 31)]; }
    __builtin_amdgcn_fence(__ATOMIC_ACQ_REL, "wavefront"); asm volatile("s_waitcnt lgkmcnt(0)" ::: "memory");
    const int cc = lane & 7;
#pragma unroll
    for (int j = 0; j < 4; ++j) { const int n = (lane >> 3) + 8 * j; const float* s = scr + (8 * cc) * 33 + n;
        u32x4 o; o.x = cvt_pk_bf16(s[0 * 33], s[1 * 33]); o.y = cvt_pk_bf16(s[2 * 33], s[3 * 33]); o.z = cvt_pk_bf16(s[4 * 33], s[5 * 33]); o.w = cvt_pk_bf16(s[6 * 33], s[7 * 33]);
        *(u32x4*)(WT + (size_t)(drow + n) * K + k0 + 8 * cc) = o; }
    asm volatile("s_waitcnt lgkmcnt(0)" ::: "memory"); __builtin_amdgcn_fence(__ATOMIC_ACQ_REL, "wavefront");
}
__device__ __forceinline__ void prep_phase(const float* x0, const float* x1, const float* g, const float* modl, int shc, int scc, bf16_t* Hh, int gw, int ngw, int lane) {
    asm volatile("" : "+v"(lane));
    for (int row = gw; row < T; row += ngw) {
        const float* xr = (row < TP ? x0 + (size_t)row * 1024 : x1 + (size_t)(row - TP) * 1024);
        const float* mp = modl + (size_t)seq_of(row) * 6144;
        f32x4 v[4]; float s = 0.f;
#pragma unroll
        for (int j = 0; j < 4; ++j) { v[j] = *(const f32x4*)(xr + 4 * lane + 256 * j); s += (v[j][0] * v[j][0] + v[j][1] * v[j][1]) + (v[j][2] * v[j][2] + v[j][3] * v[j][3]); }
        const float rs = rsqrtf(wave_sum(s) * (1.0f / 1024.0f) + EPS);
#pragma unroll
        for (int j = 0; j < 4; ++j) { const int cidx = 4 * lane + 256 * j; const f32x4 gg = *(const f32x4*)(g + cidx), sc = *(const f32x4*)(mp + scc * 1024 + cidx), sh = *(const f32x4*)(mp + shc * 1024 + cidx);
            const f32x4 y = v[j] * rs * gg * (sc + 1.0f) + sh; u32x2 w; w.x = cvt_pk_bf16(y[0], y[1]); w.y = cvt_pk_bf16(y[2], y[3]);
            *(u32x2*)(Hh + (size_t)row * 1024 + cidx) = w; }
    }
}
__device__ __forceinline__ void qkpost_phase(bf16_t* QK, int ldq, int nq_heads, int nk_heads, const float* qg, const float* kg, const f32x2* RT, int gw, int ngw, int lane) {
    asm volatile("" : "+v"(lane));
    const float gq = qg[lane] * (0.125f * LOG2E), gk = kg[lane];
    for (int row = gw; row < T; row += ngw) {
        const f32x2 cs = RT[(size_t)pos_of(row) * 32 + (lane & 31)];
        bf16_t* rp = QK + (size_t)row * ldq + lane;
        for (int h = 0; h < nq_heads + nk_heads; ++h) {
            const float x = bf2f(rp[h * 64]);
            const float ss = wave_sum(x * x);
            const float y = x * rsqrtf(ss * (1.0f / 64.0f) + EPS) * (h < nq_heads ? gq : gk);
            const float pr = __shfl_xor(y, 32);
            const float ov = lane < 32 ? (y * cs.x - pr * cs.y) : (y * cs.x + pr * cs.y);
            rp[h * 64] = f2bf(ov);
        }
    }
}

#ifndef PHASES
#define PHASES 0xFFFFFF
#endif
#define EN(b) ((PHASES >> (b)) & 1)
struct Args { const float* in[29]; float* out; unsigned char* ws; };

__global__ void __launch_bounds__(512, 2) fwd_kernel(Args args) {
    extern __shared__ __attribute__((aligned(16))) unsigned char lds[];
    cg::grid_group grid = cg::this_grid();
    const int tid = threadIdx.x, lane = tid & 63, wave = __builtin_amdgcn_readfirstlane(tid >> 6);
    const int G = gridDim.x, bx = blockIdx.x;
    const int vcu = (G % 8 == 0) ? (bx % 8) * (G / 8) + bx / 8 : bx;
    const int gw = vcu * 8 + wave, ngw = G * 8;
    const __attribute__((address_space(4))) Args* ap = (const __attribute__((address_space(4))) Args*)__builtin_amdgcn_kernarg_segment_ptr();
    asm volatile("" : "+s"(ap));
    unsigned char* ws = ap->ws;
    LAS unsigned char* lds3 = (LAS unsigned char*)lds;
#define mod ((float*)(ws + WS_MOD))
#define Hh ((bf16_t*)(ws + WS_H))
#define BIG ((bf16_t*)(ws + WS_BIG))
#define VTB ((bf16_t*)(ws + WS_VT))
#define Gh ((float*)(ws + WS_HALO))
#define RT ((const f32x2*)(ws + WS_ROPE))
#define OPQ() asm volatile("" : "+s"(ws), "+s"(out), "+s"(ap))
    float* out = ap->out;

    if (EN(0)) {
        float* cact = (float*)lds;
        for (int idx = tid; idx < NSEQ * 1024; idx += 512) { const int b = idx >> 10, k = idx & 1023; const float cv = b < 2 ? ap->in[2][b * 1024 + k] : ap->in[3][(b - 2) * 1024 + k];
            cact[idx] = cv * __builtin_amdgcn_rcpf(1.0f + __expf(-cv)); }
        __syncthreads();
        for (int item = bx + G * wave; item < 384; item += G * 8) {
            const int li = item / 96, n = (item % 96) * 64 + lane;
            const float* wp = ap->in[4] + (size_t)li * 1024 * 6144 + n;
            float acc[NSEQ];
#pragma unroll
            for (int b = 0; b < NSEQ; ++b) acc[b] = 0.f;
            for (int k4 = 0; k4 < 256; ++k4) {
                const float w0 = wp[(size_t)(4 * k4) * 6144], w1 = wp[(size_t)(4 * k4 + 1) * 6144], w2 = wp[(size_t)(4 * k4 + 2) * 6144], w3 = wp[(size_t)(4 * k4 + 3) * 6144];
#pragma unroll
                for (int b = 0; b < NSEQ; ++b) { const f32x4 cv = *(const f32x4*)(cact + b * 1024 + 4 * k4); acc[b] += (cv[0] * w0 + cv[1] * w1) + (cv[2] * w2 + cv[3] * w3); }
            }
            const float bias = ap->in[5][li * 6144 + n];
#pragma unroll
            for (int b = 0; b < NSEQ; ++b) mod[(size_t)(li * NSEQ + b) * 6144 + n] = acc[b] + bias;
        }
        __syncthreads();
        float* scr = (float*)(lds + wave * 16384);
        for (int mi = 0; mi < 18; ++mi) {
            const float* W; int K, N, mode = 0; bf16_t* WT;
            if (mi < 2) { W = ap->in[8] + (size_t)mi * 1024 * 1024; K = 1024; N = 1024; WT = (bf16_t*)(ws + WS_FNET) + (size_t)mi * 1024 * 1024; }
            else if (mi == 2) { W = ap->in[10]; K = 1024; N = 1536; WT = (bf16_t*)(ws + WS_SWAQKV); }
            else if (mi == 3) { W = ap->in[14]; K = 1024; N = 1024; WT = (bf16_t*)(ws + WS_SWAWO); }
            else if (mi == 4) { W = ap->in[15]; K = 1024; N = 3072; WT = (bf16_t*)(ws + WS_DIFFQKV); }
            else if (mi == 5) { W = ap->in[23]; K = 1024; N = 1024; WT = (bf16_t*)(ws + WS_DIFFWO); }
            else if (mi < 10) { const int l = mi - 6; W = ap->in[24] + (size_t)l * 1024 * FF; K = 1024; N = FF; WT = (bf16_t*)(ws + WS_GU + l * GU_STRIDE); mode = 1; }
            else if (mi < 14) { const int l = mi - 10; W = ap->in[25] + (size_t)l * 1024 * FF; K = 1024; N = FF; WT = (bf16_t*)(ws + WS_GU + l * GU_STRIDE); mode = 2; }
            else { const int l = mi - 14; W = ap->in[28] + (size_t)l * FF * 1024; K = FF; N = 1024; WT = (bf16_t*)(ws + WS_DOWN + l * DOWN_STRIDE); }
            const int nitems = (K / 64) * (N / 32);
            for (int it = gw; it < nitems; it += ngw) transpose_item(W, K, N, WT, mode, scr, it, lane);
        }
        const int gt = vcu * 512 + tid, ngt = G * 512;
        bf16_t* Dc = (bf16_t*)(ws + WS_DC); bf16_t* D1 = (bf16_t*)(ws + WS_D1); bf16_t* D2 = (bf16_t*)(ws + WS_D2);
        f32x2* TWp = (f32x2*)(ws + WS_TWP); f32x2* TWs = (f32x2*)(ws + WS_TWS); f32x2* RTw = (f32x2*)(ws + WS_ROPE);
        for (int e = gt; e < 512 * 256; e += ngt) { const int r = e >> 8, cc = e & 255, ri = r >> 8, kc = r & 255; const float rev = (float)((cc * kc) & 255) * (1.0f / 256.0f);
            const float v = ri == 0 ? __builtin_amdgcn_cosf(rev) : -__builtin_amdgcn_sinf(rev); Dc[e] = f2bf(v * 0.0625f); }
        const float r128 = 0.08838834764831845f;
        for (int e = gt; e < 256 * 256; e += ngt) { const int r = e >> 8, cc = e & 255, ro = r >> 7, k1 = r & 127, ri = cc >> 7, n1 = cc & 127; const float rev = (float)((n1 * k1) & 127) * (1.0f / 128.0f);
            const float cs = __builtin_amdgcn_cosf(rev), sn = __builtin_amdgcn_sinf(rev);
            const float v = ro == 0 ? (ri == 0 ? cs : sn) : (ri == 0 ? -sn : cs); D1[e] = f2bf(v * r128);
            const float v2 = ro == 0 ? (ri == 0 ? cs : sn) : 0.f; D2[e] = f2bf(v2 * r128); }
        for (int e = gt; e < 128 * 128; e += ngt) { const int k1 = e >> 7, n2 = e & 127; const float rev = (float)(n2 * k1) * (1.0f / 16384.0f); TWp[e] = (f32x2){__builtin_amdgcn_cosf(rev), __builtin_amdgcn_sinf(rev)}; }
        for (int e = gt; e < 128 * 16; e += ngt) { const int k1 = e >> 4, n2 = e & 15; const float rev = (float)(n2 * k1) * (1.0f / 2048.0f); TWs[e] = (f32x2){__builtin_amdgcn_cosf(rev), __builtin_amdgcn_sinf(rev)}; }
        for (int e = gt; e < SP * 32; e += ngt) { const int pos = e >> 5, i = e & 31; double iv = 1.0; if (i & 1) iv *= 0.7498942093324559; if (i & 2) iv *= 0.5623413251903491; if (i & 4) iv *= 0.31622776601683794; if (i & 8) iv *= 0.1; if (i & 16) iv *= 0.01;
            double rv = (double)pos * iv * 0.15915494309189535; rv -= floor(rv); const float rev = (float)rv;
            RTw[e] = (f32x2){__builtin_amdgcn_cosf(rev), __builtin_amdgcn_sinf(rev)}; }
    }
    grid.sync(); OPQ();

    for (int layer = 0; layer < 4; ++layer) {
        const int kind = layer % 3, jm = layer / 3;
        const float* modl = mod + (size_t)layer * NSEQ * 6144;
        const float* xs0 = layer == 0 ? ap->in[0] : out; const float* xs1 = layer == 0 ? ap->in[1] : out + (size_t)TP * 1024;
        if (EN(1)) prep_phase(xs0, xs1, ap->in[6] + layer * 1024, modl, 0, 1, Hh, gw, ngw, lane);
        grid.sync(); OPQ();
        const char* wo_w; const float* wo_b = nullptr;
        if (kind == 0) {
            for (int part = 0; part < 2; ++part) { ProbF0 p{256, (const char*)(ws + WS_DC), (const char*)Hh, BIG, part, G, bx}; if (EN(2)) pg8::gemm_phase(lds3, p); }
            grid.sync(); OPQ();
            { ProbF1 p{256, (const char*)(ws + WS_D1), BIG, (const f32x2*)(ws + WS_TWP), (const f32x2*)(ws + WS_TWS), G, bx}; if (EN(3)) pg8::gemm_phase(lds3, p); }
            grid.sync(); OPQ();
            { ProbF2p p{256, (const char*)(ws + WS_D2), (const char*)BIG, Hh, G, bx}; if (EN(4)) pg8::gemm_phase(lds3, p); }
            if (EN(5)) {
                constexpr float C16[16] = {1.f, 0.9238795325112867f, 0.7071067811865476f, 0.3826834323650898f, 0.f, -0.3826834323650898f, -0.7071067811865476f, -0.9238795325112867f,
                                           -1.f, -0.9238795325112867f, -0.7071067811865476f, -0.3826834323650898f, 0.f, 0.3826834323650898f, 0.7071067811865476f, 0.9238795325112867f};
                int tid2 = tid; asm volatile("" : "+v"(tid2));
                const int gt = vcu * 512 + tid2, ngt = G * 512;
                for (int it = gt; it < 128 * 32 * 1024; it += ngt) {
                    const int cch = it & 1023, b = (it >> 10) & 31, k1 = it >> 15;
                    const bf16_t* src = BIG + (size_t)cch * (2 * T) + 65536 + (size_t)(b >> 4) * 65536 + (size_t)(k1 * 16 + (b & 15)) * 32;
                    float yr[16], yi[16];
#pragma unroll
                    for (int q = 0; q < 4; ++q) { const u32x4 w = *(const u32x4*)(src + 8 * q);
#pragma unroll
                        for (int e = 0; e < 4; ++e) { const float lo = __uint_as_float(w[e] << 16), hv = __uint_as_float(w[e] & 0xffff0000u);
                            if (q < 2) { yr[8 * q + 2 * e] = lo; yr[8 * q + 2 * e + 1] = hv; } else { yi[8 * (q - 2) + 2 * e] = lo; yi[8 * (q - 2) + 2 * e + 1] = hv; } } }
                    bf16_t* dst = Hh + (size_t)(TP + b * SS + k1) * 1024 + cch;
#pragma unroll
                    for (int k2 = 0; k2 < 16; ++k2) { float acc = 0.f;
#pragma unroll
                        for (int n2 = 0; n2 < 16; ++n2) { const int mm = (n2 * k2) & 15; acc += yr[n2] * C16[mm] + yi[n2] * C16[(mm + 12) & 15]; }
                        dst[(size_t)(128 * k2) * 1024] = f2bf(acc * 0.25f); }
                }
            }
            grid.sync(); OPQ();
            wo_w = (const char*)(ws + WS_FNET + (size_t)jm * 1024 * 1024 * 2); wo_b = ap->in[9] + jm * 1024;
        } else if (kind == 1) {
            { ProbQKV p{1024, (const char*)Hh, (const char*)(ws + WS_SWAQKV), 5, 1, BIG, 1280, VTB, G, bx}; if (EN(6)) pg8::gemm_phase(lds3, p); }
            grid.sync(); OPQ();
            if (EN(7)) qkpost_phase(BIG, 1280, 16, 4, ap->in[11], ap->in[12], RT, gw, ngw, lane);
            grid.sync(); OPQ();
            {
                AttnArgs a; a.QK = BIG; a.ldq = 1280; a.VT = VTB; a.O = Hh; a.lam = 0.f; a.post = 0.f; a.subg = nullptr;
                for (int ph = 0; ph < 2; ++ph) {
                    const int NU = ph == 0 ? 2048 : 4096, nqb = ph == 0 ? 128 : 16;
                    const int u0 = (int)((long)NU * vcu / G), u1 = (int)((long)NU * (vcu + 1) / G);
                    for (int u = u0; u < u1; ++u) {
                        const int gp = u & 1, n = (u >> 1) % nqb, bk = (u >> 1) / nqb, kvh = bk & 3, b = bk >> 2;
                        a.S = ph == 0 ? SP : SS; a.seq0 = ph == 0 ? b * SP : TP + b * SS; a.qpos0 = n * 128;
                        const int hd0 = kvh * 4 + gp * 2;
                        a.qcol0 = hd0 * 64; a.kcol = 1024 + kvh * 64; a.vrow0 = kvh * 64; a.ocol0 = hd0 * 64;
                        const int lo = a.qpos0 - 128 < 0 ? 0 : a.qpos0 - 128, hi_ = a.qpos0 + 256 > a.S ? a.S : a.qpos0 + 256;
                        a.kt_lo = lo >> 6; a.kt_hi = hi_ >> 6;
                        a.sink2a = ap->in[13][hd0] * LOG2E; a.sink2b = ap->in[13][hd0 + 1] * LOG2E;
                        if (EN(8)) attn_unit<0>(lds, a);
                    }
                }
            }
            grid.sync(); OPQ();
            wo_w = (const char*)(ws + WS_SWAWO);
        } else {
            { ProbQKV p{1024, (const char*)Hh, (const char*)(ws + WS_DIFFQKV), 8, 4, BIG, 2048, VTB, G, bx}; if (EN(6)) pg8::gemm_phase(lds3, p); }
            grid.sync(); OPQ();
            if (EN(7)) qkpost_phase(BIG, 2048, 16, 16, ap->in[16], ap->in[17], RT, gw, ngw, lane);
            grid.sync(); OPQ();
            {
                float d1 = 0.f, d2 = 0.f;
                for (int i = 0; i < 64; ++i) { d1 += ap->in[18][i] * ap->in[19][i]; d2 += ap->in[20][i] * ap->in[21][i]; }
                const float lambda_init = 0.8f - 0.6f * 0.5488116360940264f;
                AttnArgs a; a.QK = BIG; a.ldq = 2048; a.VT = VTB; a.O = Hh; a.lam = __expf(d1) - __expf(d2) + lambda_init; a.post = 1.0f - lambda_init; a.subg = ap->in[22];
                a.sink2a = 0.f; a.sink2b = 0.f;
                for (int ph = 0; ph < 2; ++ph) {
                    const int NU = ph == 0 ? 2048 : 4096, nqb = ph == 0 ? 128 : 16;
                    const int u0 = (int)((long)NU * vcu / G), u1 = (int)((long)NU * (vcu + 1) / G);
                    for (int u = u0; u < u1; ++u) {
                        const int qb = u % nqb, pr = u / nqb, h = pr & 7, b = pr >> 3;
                        a.S = ph == 0 ? SP : SS; a.seq0 = ph == 0 ? b * SP : TP + b * SS; a.qpos0 = qb * 128;
                        a.qcol0 = h * 128; a.kcol = 1024 + h * 128; a.vrow0 = h * 128; a.ocol0 = h * 128;
                        a.kt_lo = 0; a.kt_hi = a.S >> 6;
                        if (EN(9)) attn_unit<1>(lds, a);
                    }
                }
            }
            grid.sync(); OPQ();
            wo_w = (const char*)(ws + WS_DIFFWO);
        }
        { ProbResid p{1024, (const char*)Hh, 2048u, wo_w, xs0, xs1, out, modl + 2 * 1024, wo_b, G, bx}; if (EN(10)) pg8::gemm_phase(lds3, p); }
        grid.sync(); OPQ();
        if (EN(1)) prep_phase(out, out + (size_t)TP * 1024, ap->in[7] + layer * 1024, modl, 3, 4, Hh, gw, ngw, lane);
        grid.sync(); OPQ();
        const char* gu = (const char*)(ws + WS_GU + layer * GU_STRIDE);
        { ProbHalo p{1024, (const char*)Hh, gu, Gh, G, bx}; if (EN(11)) pg8::gemm_phase(lds3, p); }
        grid.sync(); OPQ();
        { ProbGateUp p{1024, (const char*)Hh, gu, Gh, ap->in[26] + (size_t)layer * 3 * FF, ap->in[27] + (size_t)layer * FF, BIG, G, bx}; if (EN(12)) pg8::gemm_phase(lds3, p); }
        grid.sync(); OPQ();
        { ProbResid p{FF, (const char*)BIG, (unsigned)(FF * 2), (const char*)(ws + WS_DOWN + layer * DOWN_STRIDE), out, out + (size_t)TP * 1024, out, modl + 5 * 1024, nullptr, G, bx}; if (EN(13)) pg8::gemm_phase(lds3, p); }
        if (layer < 3) { grid.sync(); OPQ(); }
    }
}

extern "C" void kernel_launch(void* const* d_in, const int* in_sizes, int n_in, void* d_out, int out_size, void* d_ws, size_t ws_size, hipStream_t stream) {
    static int grid = 0;
    if (grid == 0) {
        if (n_in != 29 || ws_size < WS_END) { fprintf(stderr, "kernel_launch: unexpected problem (n_in %d, ws %zu)\n", n_in, ws_size); grid = -1; return; }
        int dev = 0, cus = 0, per_cu = 0;
        hipGetDevice(&dev); hipDeviceGetAttribute(&cus, hipDeviceAttributeMultiprocessorCount, dev);
        hipFuncSetAttribute((const void*)fwd_kernel, hipFuncAttributeMaxDynamicSharedMemorySize, LDS_BYTES);
        if (hipOccupancyMaxActiveBlocksPerMultiprocessor(&per_cu, (const void*)fwd_kernel, 512, LDS_BYTES) != hipSuccess || per_cu < 1) per_cu = 1;
        (void)hipGetLastError();
        grid = cus * 1;
    }
    if (grid < 0) return;
    Args a{};
    for (int i = 0; i < 29; ++i) a.in[i] = (const float*)d_in[i];
    a.out = (float*)d_out; a.ws = (unsigned char*)d_ws;
    void* kargs[] = {&a};
    hipError_t e = hipLaunchCooperativeKernel((const void*)fwd_kernel, dim3(grid), dim3(512), kargs, LDS_BYTES, stream);
    if (e != hipSuccess) fprintf(stderr, "cooperative launch failed: %s (grid %d)\n", hipGetErrorString(e), grid);
}
```

```cpp
#include <hip/hip_runtime.h>
#include <hip/hip_cooperative_groups.h>
#include <cstdio>
#include <cstdint>
#include <cmath>
#include <type_traits>
namespace cg = cooperative_groups;

#define LAS __attribute__((address_space(3)))
#define GAS __attribute__((address_space(1)))
typedef unsigned short bf16_t;
typedef short bf16x8 __attribute__((ext_vector_type(8)));
typedef short s16x4 __attribute__((ext_vector_type(4)));
typedef float f32x4 __attribute__((ext_vector_type(4)));
typedef float f32x2 __attribute__((ext_vector_type(2)));
typedef float f32x16 __attribute__((ext_vector_type(16)));
typedef unsigned u32x4 __attribute__((ext_vector_type(4)));
typedef unsigned u32x2 __attribute__((ext_vector_type(2)));

constexpr int T = 98304, TP = 32768, SP = 16384, SS = 2048, DM = 1024, FF = 2816, NSEQ = 34;
constexpr float EPS = 1e-6f;
constexpr float LOG2E = 1.4426950408889634f;
constexpr size_t MiB = 1u << 20;
constexpr size_t WS_DC = 1 * MiB, WS_D1 = WS_DC + 262144, WS_D2 = WS_D1 + 131072, WS_TWP = WS_D2 + 131072, WS_TWS = WS_TWP + 131072;
constexpr size_t WS_ROPE = 2 * MiB, WS_MOD = 6 * MiB;
constexpr size_t WS_FNET = 10 * MiB, WS_SWAQKV = 14 * MiB, WS_SWAWO = 17 * MiB, WS_DIFFQKV = 19 * MiB, WS_DIFFWO = 25 * MiB;
constexpr size_t WS_GU = 27 * MiB, GU_STRIDE = (size_t)5632 * 1024 * 2, WS_DOWN = 71 * MiB, DOWN_STRIDE = (size_t)1024 * 2816 * 2;
constexpr size_t WS_HALO = 96 * MiB, WS_H = 130 * MiB, WS_BIG = 322 * MiB, WS_VT = 706 * MiB, WS_END = 898 * MiB;
static_assert(WS_GU + 4 * GU_STRIDE <= WS_DOWN && WS_DOWN + 4 * DOWN_STRIDE <= WS_HALO, "ws map");
static_assert(WS_HALO + (size_t)3072 * 2816 * 4 <= WS_H && WS_H + (size_t)T * 1024 * 2 <= WS_BIG && WS_BIG + (size_t)T * 2048 * 2 <= WS_VT, "ws map");
static_assert(WS_BIG + (size_t)T * FF * 2 <= WS_END && WS_VT + (size_t)T * 1024 * 2 <= WS_END, "ws map");
constexpr int LDS_BYTES = 147456;

__device__ __forceinline__ unsigned cvt_pk_bf16(float lo, float hi) { unsigned r; asm volatile("v_cvt_pk_bf16_f32 %0, %1, %2" : "=v"(r) : "v"(lo), "v"(hi)); return r; }
__device__ __forceinline__ float bf2f(unsigned short b) { return __uint_as_float(((unsigned)b) << 16); }
__device__ __forceinline__ unsigned short f2bf(float f) { return (unsigned short)(cvt_pk_bf16(f, 0.f) & 0xffffu); }
__device__ __forceinline__ int seq_of(int row) { return row < TP ? (row >> 14) : 2 + ((row - TP) >> 11); }
__device__ __forceinline__ int pos_of(int row) { return row < TP ? (row & (SP - 1)) : ((row - TP) & (SS - 1)); }
__device__ __forceinline__ float wave_sum(float v) {
#pragma unroll
    for (int o = 1; o < 64; o <<= 1) v += __shfl_xor(v, o);
    return v;
}

namespace pg8 {
constexpr int BM = 256, BK = 64, HALF = 128, HTB = HALF * BK * 2, STAGE_BYTES = 8 * HTB;
__host__ __device__ __forceinline__ int lds_byte(int r, int c) { const int st = (r >> 4) * 2 + (c >> 5), rr = r & 15, cc = c & 31, ob = rr * 64 + cc * 2; return st * 1024 + (ob ^ (((ob >> 9) & 1) << 5)); }
__host__ __device__ __forceinline__ void stage_rc(int b, int& R, int& C) { const int st = b / 1024, sb = b % 1024, swz = sb ^ (((sb >> 9) & 1) << 5); R = (st >> 1) * 16 + swz / 64; C = (st & 1) * 32 + (swz % 64) / 2; }
__host__ __device__ __forceinline__ int perm32(int rho) { const int n = rho >> 4, i = rho & 15; return 8 * (i >> 2) + 4 * n + (i & 3); }
struct Unit { int pm, pn, z; };
__device__ __forceinline__ void tile_of(int L, int nM, int nN, int& pm, int& pn) {
    const int nwg = nM * nN; int wgid = L;
    { const int q = nwg / 8, r = nwg % 8, xcd = wgid % 8, off = wgid / 8; wgid = (xcd < r ? xcd * (q + 1) : r * (q + 1) + (xcd - r) * q) + off; }
    const int nig = 8 * nN, gid = wgid / nig, fm = gid * 8, gsz = (nM - fm) < 8 ? (nM - fm) : 8;
    pm = fm + ((wgid % nig) % gsz); pn = (wgid % nig) / gsz;
}
template <class P>
__device__ __forceinline__ void gemm_phase(LAS unsigned char* lds, const P& p) {
    int tid = threadIdx.x; asm volatile("" : "+v"(tid));
    const int wid = __builtin_amdgcn_readfirstlane(tid >> 6), lane = tid & 63, wr = wid >> 2, wc = wid & 3, fr = lane & 15, fq = lane >> 4;
    const int K = p.K, nt = K / BK;
    unsigned voffA[2], voffB[2];
#pragma unroll
    for (int i = 0; i < 2; ++i) { int R, C; stage_rc(tid * 16 + i * 8192, R, C); const int Rb = (R & ~31) + perm32(R & 31);
        voffA[i] = p.a_rowoff(R) + (unsigned)C * 2u; voffB[i] = p.b_rowoff(Rb) + (unsigned)C * 2u; }
    const size_t kstep = (size_t)(BK * 2);
    const size_t hstepA = p.a_hstep(), hstepB = p.b_hstep();
    const unsigned ldsw = (unsigned)wid * 1024u;
    const int aoff = lds_byte(wr * 64 + fr, fq * 8), boff = lds_byte(wc * 32 + fr, fq * 8);
#define PG8_SA(b, h) (((b) * 2 + (h)) * HTB)
#define PG8_SB(b, h) ((4 + (b) * 2 + (h)) * HTB)
#define PG8_STAGE(bufoff, gbase, voff) do { _Pragma("unroll") for (int _i = 0; _i < 2; ++_i) \
        __builtin_amdgcn_global_load_lds((const unsigned*)((const char*)(gbase) + (voff)[_i]), (LAS unsigned*)(lds + (bufoff) + ldsw + _i * 8192), 16, 0, 0); } while (0)
#define PG8_LDA(dst, b, h) do { _Pragma("unroll") for (int m = 0; m < 4; ++m) _Pragma("unroll") for (int k = 0; k < 2; ++k) dst[m][k] = *(const LAS bf16x8*)(lds + PG8_SA(b, h) + aoff + m * 2048 + k * 1024); } while (0)
#define PG8_LDB(dst, b, h) do { _Pragma("unroll") for (int n = 0; n < 2; ++n) _Pragma("unroll") for (int k = 0; k < 2; ++k) dst[n][k] = *(const LAS bf16x8*)(lds + PG8_SB(b, h) + boff + n * 2048 + k * 1024); } while (0)
#define PG8_MMA(ai, bj, At, Bt) do { __builtin_amdgcn_s_setprio(1); _Pragma("unroll") for (int m = 0; m < 4; ++m) _Pragma("unroll") for (int n = 0; n < 2; ++n) _Pragma("unroll") for (int k = 0; k < 2; ++k) \
        acc[ai][bj][m][n] = __builtin_amdgcn_mfma_f32_16x16x32_bf16(Bt[n][k], At[m][k], acc[ai][bj][m][n], 0, 0, 0); __builtin_amdgcn_s_setprio(0); } while (0)
#define PG8_WAIT_V(n) asm volatile("s_waitcnt vmcnt(" #n ")" ::: "memory")
#define PG8_WAIT_L(n) asm volatile("s_waitcnt lgkmcnt(" #n ")" ::: "memory")
#define PG8_BAR __builtin_amdgcn_s_barrier()
#define PG8_SCHED __builtin_amdgcn_sched_barrier(0)
    Unit cur, nxt; int ui = 0;
    if (!p.next(0, cur)) return;
    f32x4 acc[2][2][4][2];
#pragma unroll
    for (int a = 0; a < 2; ++a)
#pragma unroll
        for (int b = 0; b < 2; ++b)
#pragma unroll
            for (int m = 0; m < 4; ++m)
#pragma unroll
                for (int n = 0; n < 2; ++n) acc[a][b][m][n] = (f32x4){0.f, 0.f, 0.f, 0.f};
    bf16x8 At[4][2], B0[2][2], B1[2][2];
    const char* cA = p.a_base(cur); const char* cB = p.b_base(cur);
    PG8_STAGE(PG8_SB(0, 0), cB, voffB); PG8_STAGE(PG8_SB(0, 1), cB + hstepB, voffB); PG8_STAGE(PG8_SA(0, 0), cA, voffA); PG8_STAGE(PG8_SA(0, 1), cA + hstepA, voffA);
    if (wr == 1) PG8_BAR;
    PG8_WAIT_V(2); PG8_BAR;
    PG8_STAGE(PG8_SB(1, 0), cB + kstep, voffB); PG8_STAGE(PG8_SA(1, 0), cA + kstep, voffA); PG8_STAGE(PG8_SB(1, 1), cB + hstepB + kstep, voffB);
    PG8_WAIT_V(6); PG8_BAR;
    for (;;) {
        const bool has_next = p.next(ui + 1, nxt);
        const char* nA = has_next ? p.a_base(nxt) : cA; const char* nB = has_next ? p.b_base(nxt) : cB;
        for (int t = 0; t < nt; t += 2) {
            const bool last = (t == nt - 2);
            const char* a1 = cA + (size_t)(t + 1) * kstep;
            const char* a2 = last ? nA : cA + (size_t)(t + 2) * kstep; const char* b2 = last ? nB : cB + (size_t)(t + 2) * kstep;
            const char* a3 = a2 + kstep; const char* b3 = b2 + kstep;
            PG8_LDB(B0, 0, 0); PG8_LDB(B1, 0, 1); PG8_SCHED; PG8_LDA(At, 0, 0); PG8_STAGE(PG8_SA(1, 1), a1 + hstepA, voffA);
            PG8_WAIT_V(8); PG8_WAIT_L(0); PG8_BAR; PG8_MMA(0, 0, At, B0); PG8_MMA(0, 1, At, B1); PG8_BAR; PG8_SCHED;
            PG8_LDA(At, 0, 1); PG8_STAGE(PG8_SB(0, 0), b2, voffB); PG8_STAGE(PG8_SB(0, 1), b2 + hstepB, voffB); PG8_STAGE(PG8_SA(0, 0), a2, voffA);
            PG8_WAIT_V(8); PG8_WAIT_L(0); PG8_BAR; PG8_MMA(1, 0, At, B0); PG8_MMA(1, 1, At, B1); PG8_BAR; PG8_SCHED;
            PG8_LDB(B0, 1, 0); PG8_LDB(B1, 1, 1); PG8_SCHED; PG8_LDA(At, 1, 0); PG8_STAGE(PG8_SA(0, 1), a2 + hstepA, voffA);
            PG8_WAIT_V(8); PG8_WAIT_L(0); PG8_BAR; PG8_MMA(0, 0, At, B0); PG8_MMA(0, 1, At, B1); PG8_BAR; PG8_SCHED;
            PG8_LDA(At, 1, 1); PG8_STAGE(PG8_SB(1, 0), b3, voffB); PG8_STAGE(PG8_SB(1, 1), b3 + hstepB, voffB); PG8_STAGE(PG8_SA(1, 0), a3, voffA);
            PG8_WAIT_V(8); PG8_WAIT_L(0); PG8_BAR; PG8_MMA(1, 0, At, B0); PG8_MMA(1, 1, At, B1); PG8_BAR; PG8_SCHED;
        }
        if (wr == 0) PG8_BAR;
        { int fr_ = fr, fq_ = fq; asm volatile("" : "+v"(fr_), "+v"(fq_)); p.epi(acc, cur, wr, wc, fr_, fq_); }
        if (!has_next) break;
#pragma unroll
        for (int a = 0; a < 2; ++a)
#pragma unroll
            for (int b = 0; b < 2; ++b)
#pragma unroll
                for (int m = 0; m < 4; ++m)
#pragma unroll
                    for (int n = 0; n < 2; ++n) acc[a][b][m][n] = (f32x4){0.f, 0.f, 0.f, 0.f};
        cur = nxt; cA = nA; cB = nB; ++ui;
        if (wr == 1) PG8_BAR;
    }
    PG8_WAIT_V(0);
    PG8_BAR;
#undef PG8_SA
#undef PG8_SB
#undef PG8_STAGE
#undef PG8_LDA
#undef PG8_LDB
#undef PG8_MMA
#undef PG8_WAIT_V
#undef PG8_WAIT_L
#undef PG8_BAR
#undef PG8_SCHED
}
typedef f32x4 Acc[2][2][4][2];
__device__ __forceinline__ void store_tile_bf16(Acc& acc, bf16_t* base, size_t ldc, int wr, int wc, int fr, int fq) {
#pragma unroll
    for (int ai = 0; ai < 2; ++ai)
#pragma unroll
        for (int m = 0; m < 4; ++m) { bf16_t* rowp = base + (size_t)(ai * HALF + wr * 64 + m * 16 + fr) * ldc + wc * 32 + 8 * fq;
#pragma unroll
            for (int bj = 0; bj < 2; ++bj) { const f32x4 v0 = acc[ai][bj][m][0], v1 = acc[ai][bj][m][1]; u32x4 w;
                w.x = cvt_pk_bf16(v0[0], v0[1]); w.y = cvt_pk_bf16(v0[2], v0[3]); w.z = cvt_pk_bf16(v1[0], v1[1]); w.w = cvt_pk_bf16(v1[2], v1[3]);
                *(u32x4*)(rowp + bj * HALF) = w; } }
}
}
using pg8::Unit; using pg8::Acc; using pg8::tile_of;

struct ProbQKV {
    int K; const char* H; const char* W; int nqk, nv; bf16_t* QKout; int ldq; bf16_t* VTout; int G, c;
    __device__ __forceinline__ unsigned a_rowoff(int R) const { return (unsigned)R * 2048u; }
    __device__ __forceinline__ unsigned b_rowoff(int R) const { return (unsigned)R * 2048u; }
    __device__ __forceinline__ size_t a_hstep() const { return (size_t)128 * 2048; }
    __device__ __forceinline__ size_t b_hstep() const { return (size_t)128 * 2048; }
    __device__ __forceinline__ bool next(int i, Unit& u) const { long L = (long)i * G + c; const int n0 = 384 * nqk, n1 = 384 * nv;
        if (L < n0) { u.z = 0; tile_of((int)L, 384, nqk, u.pm, u.pn); return true; } L -= n0;
        if (L < n1) { u.z = 1; tile_of((int)L, nv, 384, u.pm, u.pn); return true; } return false; }
    __device__ __forceinline__ const char* a_base(const Unit& u) const { return u.z == 0 ? H + (size_t)u.pm * 256 * 2048 : W + (size_t)(nqk * 256 + u.pm * 256) * 2048; }
    __device__ __forceinline__ const char* b_base(const Unit& u) const { return u.z == 0 ? W + (size_t)u.pn * 256 * 2048 : H + (size_t)u.pn * 256 * 2048; }
    __device__ __forceinline__ void epi(Acc& acc, const Unit& u, int wr, int wc, int fr, int fq) const {
        bf16_t* base; size_t ldc;
        if (u.z == 0) { ldc = (size_t)ldq; base = QKout + (size_t)u.pm * 256 * ldc + u.pn * 256; } else { ldc = (size_t)T; base = VTout + (size_t)u.pm * 256 * ldc + u.pn * 256; }
        pg8::store_tile_bf16(acc, base, ldc, wr, wc, fr, fq);
    }
};
struct ProbResid {
    int K; const char* A; unsigned a_pitch; const char* W; const float* xin0; const float* xin1; float* out; const float* gate; const float* bias; int G, c;
    __device__ __forceinline__ unsigned a_rowoff(int R) const { return (unsigned)R * a_pitch; }
    __device__ __forceinline__ unsigned b_rowoff(int R) const { return (unsigned)R * (unsigned)(K * 2); }
    __device__ __forceinline__ size_t a_hstep() const { return (size_t)128 * a_pitch; }
    __device__ __forceinline__ size_t b_hstep() const { return (size_t)128 * K * 2; }
    __device__ __forceinline__ bool next(int i, Unit& u) const { const long L = (long)i * G + c; if (L >= 1536) return false; u.z = 0; tile_of((int)L, 384, 4, u.pm, u.pn); return true; }
    __device__ __forceinline__ const char* a_base(const Unit& u) const { return A + (size_t)u.pm * 256 * a_pitch; }
    __device__ __forceinline__ const char* b_base(const Unit& u) const { return W + (size_t)u.pn * 256 * K * 2; }
    __device__ __forceinline__ void epi(Acc& acc, const Unit& u, int wr, int wc, int fr, int fq) const {
        const int row0 = u.pm * 256; const float* gp = gate + (size_t)seq_of(row0) * 6144;
#pragma unroll
        for (int bj = 0; bj < 2; ++bj) { const int col = u.pn * 256 + bj * 128 + wc * 32 + 8 * fq;
            const f32x4 g0 = *(const f32x4*)(gp + col), g1 = *(const f32x4*)(gp + col + 4);
            f32x4 b0 = (f32x4){0.f, 0.f, 0.f, 0.f}, b1 = b0; if (bias) { b0 = *(const f32x4*)(bias + col); b1 = *(const f32x4*)(bias + col + 4); }
#pragma unroll
            for (int ai = 0; ai < 2; ++ai)
#pragma unroll
                for (int m = 0; m < 4; ++m) { const int row = row0 + ai * 128 + wr * 64 + m * 16 + fr;
                    const float* xs = (row < TP ? xin0 + (size_t)row * 1024 : xin1 + (size_t)(row - TP) * 1024) + col;
                    const f32x4 x0 = *(const f32x4*)xs, x1 = *(const f32x4*)(xs + 4);
                    float* op = out + (size_t)row * 1024 + col;
                    *(f32x4*)op = x0 + g0 * (acc[ai][bj][m][0] + b0); *(f32x4*)(op + 4) = x1 + g1 * (acc[ai][bj][m][1] + b1); } }
    }
};
struct ProbHalo {
    int K; const char* H; const char* W; float* Gh; int G, c;
    __device__ __forceinline__ unsigned a_rowoff(int R) const { return (unsigned)(64 * (R >> 1) + 63 * (R & 1)) * 2048u; }
    __device__ __forceinline__ unsigned b_rowoff(int R) const { return (unsigned)R * 2048u; }
    __device__ __forceinline__ size_t a_hstep() const { return (size_t)4096 * 2048; }
    __device__ __forceinline__ size_t b_hstep() const { return (size_t)256 * 2048; }
    __device__ __forceinline__ bool next(int i, Unit& u) const { const long L = (long)i * G + c; if (L >= 132) return false; u.z = 0; u.pm = (int)(L % 12); u.pn = (int)(L / 12); return true; }
    __device__ __forceinline__ const char* a_base(const Unit& u) const { return H + (size_t)u.pm * 8192 * 2048; }
    __device__ __forceinline__ const char* b_base(const Unit& u) const { return W + (size_t)u.pn * 512 * 2048; }
    __device__ __forceinline__ void epi(Acc& acc, const Unit& u, int wr, int wc, int fr, int fq) const {
#pragma unroll
        for (int ai = 0; ai < 2; ++ai)
#pragma unroll
            for (int m = 0; m < 4; ++m) { float* rp = Gh + (size_t)(u.pm * 256 + ai * 128 + wr * 64 + m * 16 + fr) * FF + u.pn * 256 + wc * 32 + 8 * fq;
#pragma unroll
                for (int bj = 0; bj < 2; ++bj) { *(f32x4*)(rp + bj * 128) = acc[ai][bj][m][0]; *(f32x4*)(rp + bj * 128 + 4) = acc[ai][bj][m][1]; } }
    }
};
struct ProbGateUp {
    int K; const char* H; const char* W; const float* Gh; const float* cw; const float* cb; bf16_t* act; int G, c;
    __device__ __forceinline__ unsigned a_rowoff(int R) const { return (unsigned)R * 2048u; }
    __device__ __forceinline__ unsigned b_rowoff(int R) const { return (unsigned)R * 2048u; }
    __device__ __forceinline__ size_t a_hstep() const { return (size_t)128 * 2048; }
    __device__ __forceinline__ size_t b_hstep() const { return (size_t)128 * 2048; }
    __device__ __forceinline__ bool next(int i, Unit& u) const { const long L = (long)i * G + c; if (L >= 384 * 22) return false; u.z = 0; tile_of((int)L, 384, 22, u.pm, u.pn); return true; }
    __device__ __forceinline__ const char* a_base(const Unit& u) const { return H + (size_t)u.pm * 256 * 2048; }
    __device__ __forceinline__ const char* b_base(const Unit& u) const { return W + (size_t)u.pn * 256 * 2048; }
    __device__ __forceinline__ void epi(Acc& acc, const Unit& u, int wr, int wc, int fr, int fq) const {
        const int lane = threadIdx.x & 63;
        const int colb = u.pn * 128 + wc * 32 + 8 * fq;
        float w0[8], w1[8], w2[8], bb[8];
#pragma unroll
        for (int q = 0; q < 2; ++q) { const f32x4 a = *(const f32x4*)(cw + colb + 4 * q), b = *(const f32x4*)(cw + FF + colb + 4 * q), cc = *(const f32x4*)(cw + 2 * FF + colb + 4 * q), d = *(const f32x4*)(cb + colb + 4 * q);
#pragma unroll
            for (int j = 0; j < 4; ++j) { w0[4 * q + j] = a[j]; w1[4 * q + j] = b[j]; w2[4 * q + j] = cc[j]; bb[4 * q + j] = d[j]; } }
        const int src_up = (fr == 0) ? lane + 15 : lane - 1, src_dn = (fr == 15) ? lane - 15 : lane + 1;
#pragma unroll
        for (int ai = 0; ai < 2; ++ai) {
            const int blk = u.pm * 4 + ai * 2 + wr;
            const bool first = blk < 512 ? ((blk & 255) == 0) : (((blk - 512) & 31) == 0);
            const bool lastb = blk < 512 ? ((blk & 255) == 255) : (((blk - 512) & 31) == 31);
            float hp[8], hn[8];
#pragma unroll
            for (int q = 0; q < 2; ++q) { f32x4 a = (f32x4){0.f, 0.f, 0.f, 0.f}, b = a;
                if (!first) a = *(const f32x4*)(Gh + (size_t)(2 * (blk - 1) + 1) * FF + colb + 4 * q);
                if (!lastb) b = *(const f32x4*)(Gh + (size_t)(2 * (blk + 1)) * FF + colb + 4 * q);
#pragma unroll
                for (int j = 0; j < 4; ++j) { hp[4 * q + j] = a[j]; hn[4 * q + j] = b[j]; } }
#pragma unroll
            for (int n = 0; n < 2; ++n)
#pragma unroll
                for (int j = 0; j < 4; ++j) { const int cidx = 4 * n + j; float rup[4], rdn[4];
#pragma unroll
                    for (int m = 0; m < 4; ++m) { const float gv = acc[ai][0][m][n][j]; rup[m] = __shfl(gv, src_up); rdn[m] = __shfl(gv, src_dn); }
#pragma unroll
                    for (int m = 0; m < 4; ++m) {
                        const float prev = (fr == 0) ? (m == 0 ? hp[cidx] : rup[m == 0 ? 0 : m - 1]) : rup[m];
                        const float nextv = (fr == 15) ? (m == 3 ? hn[cidx] : rdn[m == 3 ? 3 : m + 1]) : rdn[m];
                        const float cv = w0[cidx] * prev + w1[cidx] * acc[ai][0][m][n][j] + w2[cidx] * nextv + bb[cidx];
                        const float sg = __builtin_amdgcn_rcpf(1.0f + __expf(-cv));
                        acc[ai][0][m][n][j] = cv * sg * acc[ai][1][m][n][j]; } }
#pragma unroll
            for (int m = 0; m < 4; ++m) { const int row = u.pm * 256 + ai * 128 + wr * 64 + m * 16 + fr; const f32x4 v0 = acc[ai][0][m][0], v1 = acc[ai][0][m][1]; u32x4 w;
                w.x = cvt_pk_bf16(v0[0], v0[1]); w.y = cvt_pk_bf16(v0[2], v0[3]); w.z = cvt_pk_bf16(v1[0], v1[1]); w.w = cvt_pk_bf16(v1[2], v1[3]);
                *(u32x4*)(act + (size_t)row * FF + colb) = w; }
        }
    }
};
struct ProbF0 {
    int K; const char* Dc; const char* H; bf16_t* ZT; int part; int G, c;
    __device__ __forceinline__ unsigned a_rowoff(int R) const { return (unsigned)R * 512u; }
    __device__ __forceinline__ unsigned b_rowoff(int R) const { return (unsigned)R * (part == 0 ? 128u * 2048u : 16u * 2048u); }
    __device__ __forceinline__ size_t a_hstep() const { return (size_t)128 * 512; }
    __device__ __forceinline__ size_t b_hstep() const { return (size_t)2048; }
    __device__ __forceinline__ bool next(int i, Unit& u) const { const long L = (long)i * G + c; const int nct = part == 0 ? 128 : 256; if (L >= 8 * nct) return false;
        u.pn = (int)(L / 8); u.pm = (int)(L & 1); u.z = (int)((L >> 1) & 3); return true; }
    __device__ __forceinline__ const char* a_base(const Unit& u) const { return Dc + (size_t)u.pm * 256 * 512; }
    __device__ __forceinline__ const char* b_base(const Unit& u) const {
        const int ct = u.pn; const int tok = part == 0 ? (ct >> 6) * SP + 2 * (ct & 63) : TP + (ct >> 3) * SS + 2 * (ct & 7);
        return H + (size_t)tok * 2048 + u.z * 512; }
    __device__ __forceinline__ void epi(Acc& acc, const Unit& u, int wr, int wc, int fr, int fq) const {
        const int jb0 = (part == 0 ? 0 : 256) + 2 * u.pn;
#pragma unroll
        for (int ai = 0; ai < 2; ++ai)
#pragma unroll
            for (int m = 0; m < 4; ++m) { const int kc = ai * 128 + wr * 64 + m * 16 + fr; bf16_t* rp = ZT + (size_t)(u.z * 256 + kc) * (2 * T) + u.pm * 128 + wc * 32 + 8 * fq;
#pragma unroll
                for (int bj = 0; bj < 2; ++bj) { const f32x4 v0 = acc[ai][bj][m][0], v1 = acc[ai][bj][m][1]; u32x4 w;
                    w.x = cvt_pk_bf16(v0[0], v0[1]); w.y = cvt_pk_bf16(v0[2], v0[3]); w.z = cvt_pk_bf16(v1[0], v1[1]); w.w = cvt_pk_bf16(v1[2], v1[3]);
                    *(u32x4*)(rp + (size_t)(jb0 + bj) * 256) = w; } }
    }
};
struct ProbF1 {
    int K; const char* D1; bf16_t* ZT; const f32x2* TWp; const f32x2* TWs; int G, c;
    __device__ __forceinline__ unsigned a_rowoff(int R) const { return (unsigned)R * 512u; }
    __device__ __forceinline__ unsigned b_rowoff(int R) const { return (unsigned)R * 512u; }
    __device__ __forceinline__ size_t a_hstep() const { return (size_t)128 * 512; }
    __device__ __forceinline__ size_t b_hstep() const { return (size_t)128 * 512; }
    __device__ __forceinline__ bool next(int i, Unit& u) const { const long L = (long)i * G + c; if (L >= 3072) return false; u.pm = 0; u.pn = (int)(L / 3); u.z = (int)(L % 3); return true; }
    __device__ __forceinline__ const char* a_base(const Unit&) const { return D1; }
    __device__ __forceinline__ const char* b_base(const Unit& u) const { return (const char*)ZT + ((size_t)u.pn * (2 * T) + (size_t)u.z * 65536) * 2; }
    __device__ __forceinline__ void epi(Acc& acc, const Unit& u, int wr, int wc, int fr, int fq) const {
        bf16_t* reg = ZT + (size_t)u.pn * (2 * T) + (size_t)u.z * 65536;
#pragma unroll
        for (int m = 0; m < 4; ++m) { const int k1 = wr * 64 + m * 16 + fr;
#pragma unroll
            for (int bj = 0; bj < 2; ++bj) {
                int n2b; size_t off; const f32x2* tw;
                if (u.z == 0) { n2b = wc * 32 + 8 * fq; tw = TWp + k1 * 128 + n2b; off = (size_t)((k1 * 2 + bj) * 2) * 128 + n2b; }
                else { n2b = 8 * (fq & 1); const int blo = 8 * bj + 2 * wc + (fq >> 1); tw = TWs + k1 * 16 + n2b; off = (size_t)((k1 * 16 + blo) * 2) * 16 + n2b; }
                const int ro_stride = (u.z == 0) ? 128 : 16;
                float re[8], im[8];
#pragma unroll
                for (int n = 0; n < 2; ++n)
#pragma unroll
                    for (int j = 0; j < 4; ++j) { const f32x2 t = tw[4 * n + j]; const float a = acc[0][bj][m][n][j], b = acc[1][bj][m][n][j];
                        re[4 * n + j] = a * t.x + b * t.y; im[4 * n + j] = b * t.x - a * t.y; }
                u32x4 wre, wim;
                wre.x = cvt_pk_bf16(re[0], re[1]); wre.y = cvt_pk_bf16(re[2], re[3]); wre.z = cvt_pk_bf16(re[4], re[5]); wre.w = cvt_pk_bf16(re[6], re[7]);
                wim.x = cvt_pk_bf16(im[0], im[1]); wim.y = cvt_pk_bf16(im[2], im[3]); wim.z = cvt_pk_bf16(im[4], im[5]); wim.w = cvt_pk_bf16(im[6], im[7]);
                *(u32x4*)(reg + off) = wre; *(u32x4*)(reg + off + ro_stride) = wim; asm volatile("" ::: "memory"); } }
    }
};
struct ProbF2p {
    int K; const char* D2; const char* ZT; bf16_t* F; int G, c;
    __device__ __forceinline__ unsigned a_rowoff(int R) const { return (unsigned)R * 512u; }
    __device__ __forceinline__ unsigned b_rowoff(int R) const { return (unsigned)R * (unsigned)(2 * T * 2); }
    __device__ __forceinline__ size_t a_hstep() const { return (size_t)128 * 512; }
    __device__ __forceinline__ size_t b_hstep() const { return (size_t)128 * (2 * T * 2); }
    __device__ __forceinline__ bool next(int i, Unit& u) const { const long L = (long)i * G + c; if (L >= 1024) return false; u.pm = 0; u.pn = (int)(L >> 2); u.z = (int)(L & 3); return true; }
    __device__ __forceinline__ const char* a_base(const Unit&) const { return D2; }
    __device__ __forceinline__ const char* b_base(const Unit& u) const { return ZT + (size_t)u.z * 256 * (2 * T * 2) + (size_t)u.pn * 512; }
    __device__ __forceinline__ void epi(Acc& acc, const Unit& u, int wr, int wc, int fr, int fq) const {
        const int k1 = u.pn >> 1, b = u.pn & 1;
#pragma unroll
        for (int m = 0; m < 4; ++m) { const int k2 = wr * 64 + m * 16 + fr; bf16_t* rp = F + (size_t)(b * SP + k1 + 128 * k2) * 1024 + u.z * 256 + wc * 32 + 8 * fq;
#pragma unroll
            for (int bj = 0; bj < 2; ++bj) { const f32x4 v0 = acc[0][bj][m][0], v1 = acc[0][bj][m][1]; u32x4 w;
                w.x = cvt_pk_bf16(v0[0], v0[1]); w.y = cvt_pk_bf16(v0[2], v0[3]); w.z = cvt_pk_bf16(v1[0], v1[1]); w.w = cvt_pk_bf16(v1[2], v1[3]);
                *(u32x4*)(rp + bj * 128) = w; } }
    }
};

__device__ __forceinline__ int crow(int r, int hi) { return (r & 3) + 8 * (r >> 2) + 4 * hi; }
struct AttnArgs {
    const bf16_t* QK; int ldq;
    const bf16_t* VT;
    bf16_t* O;
    int seq0, S, qpos0;
    int qcol0, kcol, vrow0, ocol0;
    int kt_lo, kt_hi;
    float sink2a, sink2b;
    float lam, post;
    const float* subg;
};
template <int MODE>
__device__ __forceinline__ void attn_unit(unsigned char* lds, const AttnArgs& a) {
    constexpr int KW = MODE == 0 ? 64 : 128, DV = MODE == 0 ? 64 : 128, NDB = DV / 32, KPB = (KW + 8) * 2, VPB = 144, NLD = MODE == 0 ? 1 : 2;
    constexpr int KBUF = 64 * KPB, VBUF = DV * VPB;
    int tid = threadIdx.x; asm volatile("" : "+v"(tid));
    const int lane = tid & 63, r32 = lane & 31, hi = lane >> 5; const int wid = __builtin_amdgcn_readfirstlane(tid >> 6), wg = wid >> 2, wq = wid & 3;
    const int qrow = a.seq0 + a.qpos0 + wq * 32 + r32;
    bf16x8 qr[4];
    { const bf16_t* qp = a.QK + (size_t)qrow * a.ldq + a.qcol0 + wg * 64 + hi * 8;
#pragma unroll
      for (int d0 = 0; d0 < 4; ++d0) qr[d0] = *(const bf16x8*)(qp + d0 * 16); }
    const int coff = MODE == 0 ? 0 : wg * 64;
    const int qi = a.qpos0 + wq * 32 + r32;
    f32x16 o[NDB];
#pragma unroll
    for (int i = 0; i < NDB; ++i)
#pragma unroll
        for (int r = 0; r < 16; ++r) o[i][r] = 0.f;
    float mref = -1e30f, lrun = 0.f;
    u32x4 kreg[NLD], vreg[NLD];
    const int NT = a.kt_hi - a.kt_lo;
    auto gload_k = [&](int kt) {
#pragma unroll
        for (int i = 0; i < NLD; ++i) { const int idx = tid + 512 * i; const int key = MODE == 0 ? idx >> 3 : idx >> 4, ch = MODE == 0 ? idx & 7 : idx & 15;
            kreg[i] = *(const u32x4*)(a.QK + (size_t)(a.seq0 + kt * 64 + key) * a.ldq + a.kcol + ch * 8); } };
    auto gload_v = [&](int kt) {
#pragma unroll
        for (int i = 0; i < NLD; ++i) { const int idx = tid + 512 * i; const int d = idx >> 3, ch = idx & 7;
            vreg[i] = *(const u32x4*)(a.VT + (size_t)(a.vrow0 + d) * T + a.seq0 + kt * 64 + ch * 8); } };
    auto st_k = [&](int buf) {
#pragma unroll
        for (int i = 0; i < NLD; ++i) { const int idx = tid + 512 * i; const int key = MODE == 0 ? idx >> 3 : idx >> 4, ch = MODE == 0 ? idx & 7 : idx & 15;
            *(u32x4*)(lds + buf * KBUF + key * KPB + ch * 16) = kreg[i]; } };
    auto st_v = [&](int buf) {
#pragma unroll
        for (int i = 0; i < NLD; ++i) { const int idx = tid + 512 * i; const int d = idx >> 3, ch = idx & 7;
            unsigned char* dp = lds + 2 * KBUF + buf * VBUF + d * VPB + (ch >> 1) * 32 + (ch & 1) * 8; *(u32x2*)dp = (u32x2){vreg[i].x, vreg[i].y}; *(u32x2*)(dp + 16) = (u32x2){vreg[i].z, vreg[i].w}; } };
    auto stepf = [&](int t, auto HASQK_, auto HASPV_, f32x16 (&p)[2], f32x16 (&s)[2]) {
        constexpr bool HASQK = decltype(HASQK_)::value, HASPV = decltype(HASPV_)::value;
        if (t + 1 < NT) gload_k(a.kt_lo + t + 1);
        if (t < NT) gload_v(a.kt_lo + t);
        const unsigned char* Ks = lds + (t & 1) * KBUF + r32 * KPB + (coff + 8 * hi) * 2;
        const unsigned char* Vs = lds + 2 * KBUF + ((t + 1) & 1) * VBUF + r32 * VPB + 16 * hi;
        const f32x16 zz = (f32x16){0.f, 0.f, 0.f, 0.f, 0.f, 0.f, 0.f, 0.f, 0.f, 0.f, 0.f, 0.f, 0.f, 0.f, 0.f, 0.f};
        bf16x8 kf[8]; bf16x8 pk[2][2]; u32x4 pw[2][2];
        if (HASQK) {
#pragma unroll
            for (int j = 0; j < 3; ++j) kf[j] = *(const bf16x8*)(Ks + (j >> 2) * 32 * KPB + (j & 3) * 32);
        }
        float sum0 = 0.f, sum1 = 0.f;
#pragma unroll
        for (int j = 0; j < 8; ++j) {
            if (HASQK) { if (j + 3 < 8) kf[j + 3] = *(const bf16x8*)(Ks + ((j + 3) >> 2) * 32 * KPB + ((j + 3) & 3) * 32);
                s[j >> 2] = __builtin_amdgcn_mfma_f32_32x32x16_bf16(kf[j], qr[j & 3], (j & 3) == 0 ? zz : s[j >> 2], 0, 0, 0); }
            if (HASPV) { const int kb = j >> 2, e = (4 * j) & 15;
                sum0 += p[kb][e] + p[kb][e + 2]; sum1 += p[kb][e + 1] + p[kb][e + 3];
                const unsigned w0 = cvt_pk_bf16(p[kb][e], p[kb][e + 1]), w1 = cvt_pk_bf16(p[kb][e + 2], p[kb][e + 3]);
                if ((j & 1) == 0) { pw[kb][(j >> 1) & 1].x = w0; pw[kb][(j >> 1) & 1].y = w1; } else { pw[kb][(j >> 1) & 1].z = w0; pw[kb][(j >> 1) & 1].w = w1; } }
            __builtin_amdgcn_sched_barrier(0);
        }
        if (HASPV) { lrun += sum0 + sum1;
#pragma unroll
            for (int kb = 0; kb < 2; ++kb)
#pragma unroll
                for (int kg = 0; kg < 2; ++kg) pk[kb][kg] = __builtin_bit_cast(bf16x8, pw[kb][kg]); }
        bool resc = false; float alpha = 1.f;
        if (HASQK) {
            if (MODE == 0) { const int kp0 = (a.kt_lo + t) * 64;
#pragma unroll
                for (int kb = 0; kb < 2; ++kb)
#pragma unroll
                    for (int r = 0; r < 16; ++r) { const int dlt = qi - (kp0 + 32 * kb + crow(r, hi)); if (dlt > 128 || dlt < -128) s[kb][r] = -INFINITY; } }
            float m0 = fmaxf(fmaxf(s[0][0], s[0][1]), s[1][0]), m1 = fmaxf(fmaxf(s[0][2], s[0][3]), s[1][1]); m0 = fmaxf(fmaxf(m0, s[1][2]), s[1][3]);
#pragma unroll
            for (int r = 4; r < 16; r += 4) { m0 = fmaxf(fmaxf(m0, s[0][r]), s[0][r + 1]); m1 = fmaxf(fmaxf(m1, s[0][r + 2]), s[0][r + 3]); m0 = fmaxf(fmaxf(m0, s[1][r]), s[1][r + 1]); m1 = fmaxf(fmaxf(m1, s[1][r + 2]), s[1][r + 3]); }
            float rm = fmaxf(m0, m1); rm = fmaxf(rm, __shfl_xor(rm, 32));
            resc = __any(rm - mref > 8.0f);
            if (resc) { const float mnew = fmaxf(mref, rm); alpha = __builtin_amdgcn_exp2f(mref - mnew); mref = mnew; }
        }
        __builtin_amdgcn_sched_barrier(0);
        constexpr int NPV = 4 * NDB, EPG = 32 / NPV;
        if (HASPV) {
            bf16x8 vf[NPV];
            auto vread = [&](int jj) { const int i = jj >> 2, kb = (jj >> 1) & 1, kg = jj & 1; vf[jj] = *(const bf16x8*)(Vs + 32 * i * VPB + (32 * kb + 16 * kg) * 2); };
            vread(0); vread(1); vread(2);
#pragma unroll
            for (int jj = 0; jj < NPV; ++jj) {
                if (jj + 3 < NPV) vread(jj + 3);
                o[jj >> 2] = __builtin_amdgcn_mfma_f32_32x32x16_bf16(vf[jj], pk[(jj >> 1) & 1][jj & 1], o[jj >> 2], 0, 0, 0);
                if (HASQK) {
#pragma unroll
                    for (int q = 0; q < EPG; ++q) { const int e = jj * EPG + q; s[e >> 4][e & 15] = __builtin_amdgcn_exp2f(s[e >> 4][e & 15] - mref); }
                    asm volatile("" : "+v"(s[(jj * EPG) >> 4])); }
                __builtin_amdgcn_sched_barrier(0);
            }
        } else if (HASQK) {
#pragma unroll
            for (int e = 0; e < 32; ++e) s[e >> 4][e & 15] = __builtin_amdgcn_exp2f(s[e >> 4][e & 15] - mref);
        }
        if (resc) { lrun *= alpha;
#pragma unroll
            for (int i = 0; i < NDB; ++i)
#pragma unroll
                for (int r = 0; r < 16; ++r) o[i][r] *= alpha; }
        if (t + 1 < NT) st_k((t + 1) & 1);
        if (t < NT) st_v(t & 1);
        __syncthreads();
    };
    __syncthreads();
    gload_k(a.kt_lo); st_k(0);
    __syncthreads();
    f32x16 sA[2], sB[2];
    {
        const std::true_type TT{}; const std::false_type FF_{};
        stepf(0, TT, FF_, sB, sA);
        for (int t = 1; t < NT - 1; t += 2) { stepf(t, TT, TT, sA, sB); stepf(t + 1, TT, TT, sB, sA); }
        stepf(NT - 1, TT, TT, sA, sB);
        stepf(NT, FF_, TT, sB, sA);
    }
    const float ltot = lrun + __shfl_xor(lrun, 32);
    if (MODE == 0) {
        const float sk = wg == 0 ? a.sink2a : a.sink2b; const float mf = fmaxf(mref, sk), al = __builtin_amdgcn_exp2f(mref - mf);
        const float inv = al / (ltot * al + __builtin_amdgcn_exp2f(sk - mf));
        bf16_t* op = a.O + (size_t)qrow * 1024 + a.ocol0 + wg * 64 + 4 * hi;
#pragma unroll
        for (int i = 0; i < NDB; ++i)
#pragma unroll
            for (int rq = 0; rq < 4; ++rq) { u32x2 w; w.x = cvt_pk_bf16(o[i][4 * rq] * inv, o[i][4 * rq + 1] * inv); w.y = cvt_pk_bf16(o[i][4 * rq + 2] * inv, o[i][4 * rq + 3] * inv);
                *(u32x2*)(op + 32 * i + 8 * rq) = w; }
    } else {
        const float inv = 1.0f / ltot;
        float* X = (float*)lds;
        if (wg == 1) {
#pragma unroll
            for (int i = 0; i < NDB; ++i)
#pragma unroll
                for (int rq = 0; rq < 4; ++rq) *(f32x4*)(X + (wq * 32 + r32) * 132 + 32 * i + 8 * rq + 4 * hi) = (f32x4){o[i][4 * rq] * inv, o[i][4 * rq + 1] * inv, o[i][4 * rq + 2] * inv, o[i][4 * rq + 3] * inv};
        }
        __syncthreads();
        if (wg == 0) {
            float ss = 0.f;
#pragma unroll
            for (int i = 0; i < NDB; ++i)
#pragma unroll
                for (int rq = 0; rq < 4; ++rq) { const f32x4 x1 = *(const f32x4*)(X + (wq * 32 + r32) * 132 + 32 * i + 8 * rq + 4 * hi);
#pragma unroll
                    for (int j = 0; j < 4; ++j) { const float v = o[i][4 * rq + j] * inv - a.lam * x1[j]; o[i][4 * rq + j] = v; ss += v * v; } }
            ss += __shfl_xor(ss, 32);
            const float rs = rsqrtf(ss * (1.0f / 128.0f) + EPS) * a.post;
            bf16_t* op = a.O + (size_t)qrow * 1024 + a.ocol0 + 4 * hi;
#pragma unroll
            for (int i = 0; i < NDB; ++i)
#pragma unroll
                for (int rq = 0; rq < 4; ++rq) { const f32x4 g = *(const f32x4*)(a.subg + 32 * i + 8 * rq + 4 * hi); u32x2 w;
                    w.x = cvt_pk_bf16(o[i][4 * rq] * rs * g[0], o[i][4 * rq + 1] * rs * g[1]); w.y = cvt_pk_bf16(o[i][4 * rq + 2] * rs * g[2], o[i][4 * rq + 3] * rs * g[3]);
                    *(u32x2*)(op + 32 * i + 8 * rq) = w; }
        }
    }
}

__device__ __forceinline__ void transpose_item(const float* W, int K, int N, bf16_t* WT, int mode, float* scr, int item, int lane) {
    const int nblk = N / 32, kb = item / nblk, nb = item % nblk, k0 = 64 * kb, n0 = 32 * nb;
    const int drow = mode == 0 ? n0 : ((n0 >> 7) * 256 + (n0 & 127) + (mode == 2 ? 128 : 0));
#pragma unroll 8
    for (int i = 0; i < 32; ++i) { const int kk = 2 * i + (lane >> 5); scr[kk * 33 + (lane & 31)] = W[(size_t)(k0 + kk) * N + n0 + (lane & 31)]; }
    __builtin_amdgcn_fence(__ATOMIC_ACQ_REL, "wavefront"); asm volatile("s_waitcnt lgkmcnt(0)" ::: "memory");
    const int cc = lane & 7;
#pragma unroll
    for (int j = 0; j < 4; ++j) { const int n = (lane >> 3) + 8 * j; const float* s = scr + (8 * cc) * 33 + n;
        u32x4 o; o.x = cvt_pk_bf16(s[0 * 33], s[1 * 33]); o.y = cvt_pk_bf16(s[2 * 33], s[3 * 33]); o.z = cvt_pk_bf16(s[4 * 33], s[5 * 33]); o.w = cvt_pk_bf16(s[6 * 33], s[7 * 33]);
        *(u32x4*)(WT + (size_t)(drow + n) * K + k0 + 8 * cc) = o; }
    asm volatile("s_waitcnt lgkmcnt(0)" ::: "memory"); __builtin_amdgcn_fence(__ATOMIC_ACQ_REL, "wavefront");
}
__device__ __forceinline__ void prep_phase(const float* x0, const float* x1, const float* g, const float* modl, int shc, int scc, bf16_t* Hh, int gw, int ngw, int lane) {
    asm volatile("" : "+v"(lane));
    for (int row = gw; row < T; row += ngw) {
        const float* xr = (row < TP ? x0 + (size_t)row * 1024 : x1 + (size_t)(row - TP) * 1024);
        const float* mp = modl + (size_t)seq_of(row) * 6144;
        f32x4 v[4]; float s = 0.f;
#pragma unroll
        for (int j = 0; j < 4; ++j) { v[j] = *(const f32x4*)(xr + 4 * lane + 256 * j); s += (v[j][0] * v[j][0] + v[j][1] * v[j][1]) + (v[j][2] * v[j][2] + v[j][3] * v[j][3]); }
        const float rs = rsqrtf(wave_sum(s) * (1.0f / 1024.0f) + EPS);
#pragma unroll
        for (int j = 0; j < 4; ++j) { const int cidx = 4 * lane + 256 * j; const f32x4 gg = *(const f32x4*)(g + cidx), sc = *(const f32x4*)(mp + scc * 1024 + cidx), sh = *(const f32x4*)(mp + shc * 1024 + cidx);
            const f32x4 y = v[j] * rs * gg * (sc + 1.0f) + sh; u32x2 w; w.x = cvt_pk_bf16(y[0], y[1]); w.y = cvt_pk_bf16(y[2], y[3]);
            *(u32x2*)(Hh + (size_t)row * 1024 + cidx) = w; }
    }
}
__device__ __forceinline__ void qkpost_phase(bf16_t* QK, int ldq, int nq_heads, int nk_heads, const float* qg, const float* kg, const f32x2* RT, int gw, int ngw, int lane) {
    asm volatile("" : "+v"(lane));
    const float gq = qg[lane] * (0.125f * LOG2E), gk = kg[lane];
    for (int row = gw; row < T; row += ngw) {
        const f32x2 cs = RT[(size_t)pos_of(row) * 32 + (lane & 31)];
        bf16_t* rp = QK + (size_t)row * ldq + lane;
        for (int h = 0; h < nq_heads + nk_heads; ++h) {
            const float x = bf2f(rp[h * 64]);
            const float ss = wave_sum(x * x);
            const float y = x * rsqrtf(ss * (1.0f / 64.0f) + EPS) * (h < nq_heads ? gq : gk);
            const float pr = __shfl_xor(y, 32);
            const float ov = lane < 32 ? (y * cs.x - pr * cs.y) : (y * cs.x + pr * cs.y);
            rp[h * 64] = f2bf(ov);
        }
    }
}


#define XB_TMO      128
#define XB_XCNT(j)  (256  + 64 * (j))
#define XB_XSUB(j)  (1280 + 64 * (j))
#define XB_XGEN(j)  (2304 + 64 * (j))
#define XB_TOP      3328
#define XB_TOPGEN   3392
#define XCD_BAR_WORDS 3456
#define XB_SPIN_CAP (1u << 22)
__device__ __forceinline__ unsigned xb_ld(unsigned* p)              { return __hip_atomic_load(p, __ATOMIC_RELAXED, __HIP_MEMORY_SCOPE_AGENT); }
__device__ __forceinline__ unsigned xb_add(unsigned* p, unsigned v) { return __hip_atomic_fetch_add(p, v, __ATOMIC_RELAXED, __HIP_MEMORY_SCOPE_AGENT); }
__device__ __forceinline__ unsigned xb_xcc_id() { return (unsigned)__builtin_amdgcn_s_getreg((3 << 11) | 20) & 0xFu; }
#define XB_SPIN(cond, bar) do { unsigned _sp = 0; while (cond) { __builtin_amdgcn_s_sleep(1); \
    if ((++_sp & 255u) == 0u) { if (xb_ld(&(bar)[XB_TMO])) break; if (_sp > XB_SPIN_CAP) { atomicAdd(&(bar)[XB_TMO], 1u); break; } } } } while (0)
struct XcdBarrier { unsigned* bar; unsigned x; volatile LAS unsigned* st; };
__device__ __forceinline__ XcdBarrier xcd_barrier_post(unsigned* bar, volatile LAS unsigned* st) {
    XcdBarrier b; b.bar = bar; b.x = xb_xcc_id(); b.st = st;
    if (threadIdx.x == 0) (void)xb_add(&bar[XB_XCNT(b.x)], 1u);
    return b;
}
__device__ __forceinline__ void xcd_barrier_complete(unsigned* bar, unsigned x, unsigned& nloc, unsigned& nx) {
    const unsigned G = gridDim.x * gridDim.y * gridDim.z;
    unsigned sum, cnt, mine, sp = 0u;
    for (;;) {
        sum = 0u; cnt = 0u; mine = 0u;
#pragma unroll
        for (unsigned j = 0; j < 16; ++j) { const unsigned c = xb_ld(&bar[XB_XCNT(j)]); sum += c; cnt += (c > 0u) ? 1u : 0u; mine = (j == x) ? c : mine; }
        if (sum == G) break;
        __builtin_amdgcn_s_sleep(1);
        if ((++sp & 255u) == 0u) { if (xb_ld(&bar[XB_TMO])) break; if (sp > XB_SPIN_CAP) { atomicAdd(&bar[XB_TMO], 1u); break; } }
    }
    nloc = mine > 0u ? mine : 1u; nx = cnt > 0u ? cnt : 1u;
}
__device__ __forceinline__ void xcd_barrier(const XcdBarrier& b) {
    asm volatile("s_waitcnt vmcnt(0)" ::: "memory");
    __syncthreads();
    if (threadIdx.x == 0) {
        unsigned* bar = b.bar;
        __builtin_amdgcn_s_waitcnt(0);
        unsigned nloc = b.st[0], nx = b.st[1];
        if (nloc == 0u) { xcd_barrier_complete(bar, b.x, nloc, nx); b.st[0] = nloc; b.st[1] = nx; }
        const unsigned old = xb_add(&bar[XB_XSUB(b.x)], 1u);
        const unsigned gen = old / nloc;
        if (old + 1u == (gen + 1u) * nloc) {
            __builtin_amdgcn_fence(__ATOMIC_RELEASE, "agent");
            asm volatile("s_waitcnt vmcnt(0)" ::: "memory");
            const unsigned og = xb_add(&bar[XB_TOP], 1u);
            const unsigned tg = og / nx;
            if (og + 1u == (tg + 1u) * nx) xb_add(&bar[XB_TOPGEN], 1u);
            else XB_SPIN(xb_ld(&bar[XB_TOPGEN]) == tg, bar);
            __builtin_amdgcn_fence(__ATOMIC_ACQUIRE, "agent");
            xb_add(&bar[XB_XGEN(b.x)], 1u);
            asm volatile("s_waitcnt vmcnt(0)" ::: "memory");
        } else {
            XB_SPIN(xb_ld(&bar[XB_XGEN(b.x)]) == gen, bar);
            __builtin_amdgcn_fence(__ATOMIC_ACQUIRE, "agent");
            asm volatile("s_waitcnt vmcnt(0)" ::: "memory");
        }
    }
    __syncthreads();
}

#ifndef PHASES
#define PHASES 0xFFFFFF
#endif
#define EN(b) ((PHASES >> (b)) & 1)
struct Args { const float* in[29]; float* out; unsigned char* ws; };

__global__ void __launch_bounds__(512, 2) fwd_kernel(Args args) {
    extern __shared__ __attribute__((aligned(16))) unsigned char lds[];
    cg::grid_group grid = cg::this_grid();
    const int tid = threadIdx.x, lane = tid & 63, wave = __builtin_amdgcn_readfirstlane(tid >> 6);
    const int G = gridDim.x, bx = blockIdx.x;
    const int vcu = (G % 8 == 0) ? (bx % 8) * (G / 8) + bx / 8 : bx;
    const int gw = vcu * 8 + wave, ngw = G * 8;
    __builtin_assume(gw >= 0 && gw < 8192 && ngw >= 8 && ngw <= 8192 && G >= 1 && G <= 1024);
    const __attribute__((address_space(4))) Args* ap = (const __attribute__((address_space(4))) Args*)__builtin_amdgcn_kernarg_segment_ptr();
    asm volatile("" : "+s"(ap));
    unsigned long long wsi = (unsigned long long)ap->ws, outi = (unsigned long long)ap->out;
#define ws ((unsigned char*)(GAS unsigned char*)wsi)
#define out ((float*)(GAS float*)outi)
#define INP(i) ((const float*)(const GAS float*)(ap->in[i]))
    LAS unsigned char* lds3 = (LAS unsigned char*)lds;
#define mod ((float*)(ws + WS_MOD))
#define Hh ((bf16_t*)(ws + WS_H))
#define BIG ((bf16_t*)(ws + WS_BIG))
#define VTB ((bf16_t*)(ws + WS_VT))
#define Gh ((float*)(ws + WS_HALO))
#define RT ((const f32x2*)(ws + WS_ROPE))
#define OPQ() asm volatile("" : "+s"(wsi), "+s"(outi), "+s"(ap))
    if (tid < 16) ((LAS unsigned*)(lds3 + LDS_BYTES - 64))[tid] = 0u;
    __syncthreads();
    XcdBarrier xbar = xcd_barrier_post((unsigned*)ws, (volatile LAS unsigned*)(lds3 + LDS_BYTES - 64));
#define GSYNC() do { xcd_barrier(xbar); OPQ(); } while (0)

    if (EN(0)) {
        float* cact = (float*)lds;
        for (int idx = tid; idx < NSEQ * 1024; idx += 512) { const int b = idx >> 10, k = idx & 1023; const float cv = b < 2 ? INP(2)[b * 1024 + k] : INP(3)[(b - 2) * 1024 + k];
            cact[idx] = cv * __builtin_amdgcn_rcpf(1.0f + __expf(-cv)); }
        __syncthreads();
        for (int item = bx + G * wave; item < 384; item += G * 8) {
            const int li = item / 96, n = (item % 96) * 64 + lane;
            const float* wp = INP(4) + (size_t)li * 1024 * 6144 + n;
            float acc[NSEQ];
#pragma unroll
            for (int b = 0; b < NSEQ; ++b) acc[b] = 0.f;
            for (int k4 = 0; k4 < 256; ++k4) {
                const float w0 = wp[(size_t)(4 * k4) * 6144], w1 = wp[(size_t)(4 * k4 + 1) * 6144], w2 = wp[(size_t)(4 * k4 + 2) * 6144], w3 = wp[(size_t)(4 * k4 + 3) * 6144];
#pragma unroll
                for (int b = 0; b < NSEQ; ++b) { const f32x4 cv = *(const f32x4*)(cact + b * 1024 + 4 * k4); acc[b] += (cv[0] * w0 + cv[1] * w1) + (cv[2] * w2 + cv[3] * w3); }
            }
            const float bias = INP(5)[li * 6144 + n];
#pragma unroll
            for (int b = 0; b < NSEQ; ++b) mod[(size_t)(li * NSEQ + b) * 6144 + n] = acc[b] + bias;
        }
        __syncthreads();
        float* scr = (float*)(lds + wave * 16384);
        for (int mi = 0; mi < 18; ++mi) {
            const float* W; int K, N, mode = 0; bf16_t* WT;
            if (mi < 2) { W = INP(8) + (size_t)mi * 1024 * 1024; K = 1024; N = 1024; WT = (bf16_t*)(ws + WS_FNET) + (size_t)mi * 1024 * 1024; }
            else if (mi == 2) { W = INP(10); K = 1024; N = 1536; WT = (bf16_t*)(ws + WS_SWAQKV); }
            else if (mi == 3) { W = INP(14); K = 1024; N = 1024; WT = (bf16_t*)(ws + WS_SWAWO); }
            else if (mi == 4) { W = INP(15); K = 1024; N = 3072; WT = (bf16_t*)(ws + WS_DIFFQKV); }
            else if (mi == 5) { W = INP(23); K = 1024; N = 1024; WT = (bf16_t*)(ws + WS_DIFFWO); }
            else if (mi < 10) { const int l = mi - 6; W = INP(24) + (size_t)l * 1024 * FF; K = 1024; N = FF; WT = (bf16_t*)(ws + WS_GU + l * GU_STRIDE); mode = 1; }
            else if (mi < 14) { const int l = mi - 10; W = INP(25) + (size_t)l * 1024 * FF; K = 1024; N = FF; WT = (bf16_t*)(ws + WS_GU + l * GU_STRIDE); mode = 2; }
            else { const int l = mi - 14; W = INP(28) + (size_t)l * FF * 1024; K = FF; N = 1024; WT = (bf16_t*)(ws + WS_DOWN + l * DOWN_STRIDE); }
            const int nitems = (K / 64) * (N / 32);
            for (int it = gw; it < nitems; it += ngw) transpose_item(W, K, N, WT, mode, scr, it, lane);
        }
        const int gt = vcu * 512 + tid, ngt = G * 512;
        bf16_t* Dc = (bf16_t*)(ws + WS_DC); bf16_t* D1 = (bf16_t*)(ws + WS_D1); bf16_t* D2 = (bf16_t*)(ws + WS_D2);
        f32x2* TWp = (f32x2*)(ws + WS_TWP); f32x2* TWs = (f32x2*)(ws + WS_TWS); f32x2* RTw = (f32x2*)(ws + WS_ROPE);
        for (int e = gt; e < 512 * 256; e += ngt) { const int r = e >> 8, cc = e & 255, ri = r >> 8, kc = r & 255; const float rev = (float)((cc * kc) & 255) * (1.0f / 256.0f);
            const float v = ri == 0 ? __builtin_amdgcn_cosf(rev) : -__builtin_amdgcn_sinf(rev); Dc[e] = f2bf(v * 0.0625f); }
        const float r128 = 0.08838834764831845f;
        for (int e = gt; e < 256 * 256; e += ngt) { const int r = e >> 8, cc = e & 255, ro = r >> 7, k1 = r & 127, ri = cc >> 7, n1 = cc & 127; const float rev = (float)((n1 * k1) & 127) * (1.0f / 128.0f);
            const float cs = __builtin_amdgcn_cosf(rev), sn = __builtin_amdgcn_sinf(rev);
            const float v = ro == 0 ? (ri == 0 ? cs : sn) : (ri == 0 ? -sn : cs); D1[e] = f2bf(v * r128);
            const float v2 = ro == 0 ? (ri == 0 ? cs : sn) : 0.f; D2[e] = f2bf(v2 * r128); }
        for (int e = gt; e < 128 * 128; e += ngt) { const int k1 = e >> 7, n2 = e & 127; const float rev = (float)(n2 * k1) * (1.0f / 16384.0f); TWp[e] = (f32x2){__builtin_amdgcn_cosf(rev), __builtin_amdgcn_sinf(rev)}; }
        for (int e = gt; e < 128 * 16; e += ngt) { const int k1 = e >> 4, n2 = e & 15; const float rev = (float)(n2 * k1) * (1.0f / 2048.0f); TWs[e] = (f32x2){__builtin_amdgcn_cosf(rev), __builtin_amdgcn_sinf(rev)}; }
        for (int e = gt; e < SP * 32; e += ngt) { const int pos = e >> 5, i = e & 31; double iv = 1.0; if (i & 1) iv *= 0.7498942093324559; if (i & 2) iv *= 0.5623413251903491; if (i & 4) iv *= 0.31622776601683794; if (i & 8) iv *= 0.1; if (i & 16) iv *= 0.01;
            double rv = (double)pos * iv * 0.15915494309189535; rv -= floor(rv); const float rev = (float)rv;
            RTw[e] = (f32x2){__builtin_amdgcn_cosf(rev), __builtin_amdgcn_sinf(rev)}; }
    }
    grid.sync(); OPQ();

    for (int layer = 0; layer < 4; ++layer) {
        const int kind = layer % 3, jm = layer / 3;
        const float* modl = mod + (size_t)layer * NSEQ * 6144;
        const float* xs0 = layer == 0 ? INP(0) : out; const float* xs1 = layer == 0 ? INP(1) : out + (size_t)TP * 1024;
        if (EN(1)) prep_phase(xs0, xs1, INP(6) + layer * 1024, modl, 0, 1, Hh, gw, ngw, lane);
        GSYNC();
        const char* wo_w; const float* wo_b = nullptr;
        if (kind == 0) {
            for (int part = 0; part < 2; ++part) { ProbF0 p{256, (const char*)(ws + WS_DC), (const char*)Hh, BIG, part, G, bx}; if (EN(2)) pg8::gemm_phase(lds3, p); }
            GSYNC();
            { ProbF1 p{256, (const char*)(ws + WS_D1), BIG, (const f32x2*)(ws + WS_TWP), (const f32x2*)(ws + WS_TWS), G, bx}; if (EN(3)) pg8::gemm_phase(lds3, p); }
            GSYNC();
            { ProbF2p p{256, (const char*)(ws + WS_D2), (const char*)BIG, Hh, G, bx}; if (EN(4)) pg8::gemm_phase(lds3, p); }
            if (EN(5)) {
                constexpr float C16[16] = {1.f, 0.9238795325112867f, 0.7071067811865476f, 0.3826834323650898f, 0.f, -0.3826834323650898f, -0.7071067811865476f, -0.9238795325112867f,
                                           -1.f, -0.9238795325112867f, -0.7071067811865476f, -0.3826834323650898f, 0.f, 0.3826834323650898f, 0.7071067811865476f, 0.9238795325112867f};
                int tid2 = tid; asm volatile("" : "+v"(tid2));
                const int gt = vcu * 512 + tid2, ngt = G * 512;
                for (int it = gt; it < 128 * 32 * 1024; it += ngt) {
                    const int cch = it & 1023, b = (it >> 10) & 31, k1 = it >> 15;
                    const bf16_t* src = BIG + (size_t)cch * (2 * T) + 65536 + (size_t)(b >> 4) * 65536 + (size_t)(k1 * 16 + (b & 15)) * 32;
                    float yr[16], yi[16];
#pragma unroll
                    for (int q = 0; q < 4; ++q) { const u32x4 w = *(const u32x4*)(src + 8 * q);
#pragma unroll
                        for (int e = 0; e < 4; ++e) { const float lo = __uint_as_float(w[e] << 16), hv = __uint_as_float(w[e] & 0xffff0000u);
                            if (q < 2) { yr[8 * q + 2 * e] = lo; yr[8 * q + 2 * e + 1] = hv; } else { yi[8 * (q - 2) + 2 * e] = lo; yi[8 * (q - 2) + 2 * e + 1] = hv; } } }
                    bf16_t* dst = Hh + (size_t)(TP + b * SS + k1) * 1024 + cch;
#pragma unroll
                    for (int k2 = 0; k2 < 16; ++k2) { float acc = 0.f;
#pragma unroll
                        for (int n2 = 0; n2 < 16; ++n2) { const int mm = (n2 * k2) & 15; acc += yr[n2] * C16[mm] + yi[n2] * C16[(mm + 12) & 15]; }
                        dst[(size_t)(128 * k2) * 1024] = f2bf(acc * 0.25f); }
                }
            }
            GSYNC();
            wo_w = (const char*)(ws + WS_FNET + (size_t)jm * 1024 * 1024 * 2); wo_b = INP(9) + jm * 1024;
        } else if (kind == 1) {
            { ProbQKV p{1024, (const char*)Hh, (const char*)(ws + WS_SWAQKV), 5, 1, BIG, 1280, VTB, G, bx}; if (EN(6)) pg8::gemm_phase(lds3, p); }
            GSYNC();
            if (EN(7)) qkpost_phase(BIG, 1280, 16, 4, INP(11), INP(12), RT, gw, ngw, lane);
            GSYNC();
            {
                AttnArgs a; a.QK = BIG; a.ldq = 1280; a.VT = VTB; a.O = Hh; a.lam = 0.f; a.post = 0.f; a.subg = nullptr;
                for (int ph = 0; ph < 2; ++ph) {
                    const int NU = ph == 0 ? 2048 : 4096, nqb = ph == 0 ? 128 : 16;
                    const int u0 = (int)((long)NU * vcu / G), u1 = (int)((long)NU * (vcu + 1) / G);
                    for (int u = u0; u < u1; ++u) {
                        const int gp = u & 1, n = (u >> 1) % nqb, bk = (u >> 1) / nqb, kvh = bk & 3, b = bk >> 2;
                        a.S = ph == 0 ? SP : SS; a.seq0 = ph == 0 ? b * SP : TP + b * SS; a.qpos0 = n * 128;
                        const int hd0 = kvh * 4 + gp * 2;
                        a.qcol0 = hd0 * 64; a.kcol = 1024 + kvh * 64; a.vrow0 = kvh * 64; a.ocol0 = hd0 * 64;
                        const int lo = a.qpos0 - 128 < 0 ? 0 : a.qpos0 - 128, hi_ = a.qpos0 + 256 > a.S ? a.S : a.qpos0 + 256;
                        a.kt_lo = lo >> 6; a.kt_hi = hi_ >> 6;
                        a.sink2a = INP(13)[hd0] * LOG2E; a.sink2b = INP(13)[hd0 + 1] * LOG2E;
                        if (EN(8)) attn_unit<0>(lds, a);
                    }
                }
            }
            GSYNC();
            wo_w = (const char*)(ws + WS_SWAWO);
        } else {
            { ProbQKV p{1024, (const char*)Hh, (const char*)(ws + WS_DIFFQKV), 8, 4, BIG, 2048, VTB, G, bx}; if (EN(6)) pg8::gemm_phase(lds3, p); }
            GSYNC();
            if (EN(7)) qkpost_phase(BIG, 2048, 16, 16, INP(16), INP(17), RT, gw, ngw, lane);
            GSYNC();
            {
                float d1 = 0.f, d2 = 0.f;
                for (int i = 0; i < 64; ++i) { d1 += INP(18)[i] * INP(19)[i]; d2 += INP(20)[i] * INP(21)[i]; }
                const float lambda_init = 0.8f - 0.6f * 0.5488116360940264f;
                AttnArgs a; a.QK = BIG; a.ldq = 2048; a.VT = VTB; a.O = Hh; a.lam = __expf(d1) - __expf(d2) + lambda_init; a.post = 1.0f - lambda_init; a.subg = INP(22);
                a.sink2a = 0.f; a.sink2b = 0.f;
                for (int ph = 0; ph < 2; ++ph) {
                    const int NU = ph == 0 ? 2048 : 4096, nqb = ph == 0 ? 128 : 16;
                    const int u0 = (int)((long)NU * vcu / G), u1 = (int)((long)NU * (vcu + 1) / G);
                    for (int u = u0; u < u1; ++u) {
                        const int qb = u % nqb, pr = u / nqb, h = pr & 7, b = pr >> 3;
                        a.S = ph == 0 ? SP : SS; a.seq0 = ph == 0 ? b * SP : TP + b * SS; a.qpos0 = qb * 128;
                        a.qcol0 = h * 128; a.kcol = 1024 + h * 128; a.vrow0 = h * 128; a.ocol0 = h * 128;
                        a.kt_lo = 0; a.kt_hi = a.S >> 6;
                        if (EN(9)) attn_unit<1>(lds, a);
                    }
                }
            }
            GSYNC();
            wo_w = (const char*)(ws + WS_DIFFWO);
        }
        { ProbResid p{1024, (const char*)Hh, 2048u, wo_w, xs0, xs1, out, modl + 2 * 1024, wo_b, G, bx}; if (EN(10)) pg8::gemm_phase(lds3, p); }
        GSYNC();
        if (EN(1)) prep_phase(out, out + (size_t)TP * 1024, INP(7) + layer * 1024, modl, 3, 4, Hh, gw, ngw, lane);
        GSYNC();
        const char* gu = (const char*)(ws + WS_GU + layer * GU_STRIDE);
        { ProbHalo p{1024, (const char*)Hh, gu, Gh, G, bx}; if (EN(11)) pg8::gemm_phase(lds3, p); }
        GSYNC();
        { ProbGateUp p{1024, (const char*)Hh, gu, Gh, INP(26) + (size_t)layer * 3 * FF, INP(27) + (size_t)layer * FF, BIG, G, bx}; if (EN(12)) pg8::gemm_phase(lds3, p); }
        GSYNC();
        { ProbResid p{FF, (const char*)BIG, (unsigned)(FF * 2), (const char*)(ws + WS_DOWN + layer * DOWN_STRIDE), out, out + (size_t)TP * 1024, out, modl + 5 * 1024, nullptr, G, bx}; if (EN(13)) pg8::gemm_phase(lds3, p); }
        if (layer < 3) GSYNC();
    }
}

#undef ws
#undef out
#undef INP
#undef OPQ
#undef GSYNC
#undef mod
#undef Hh
#undef BIG
#undef VTB
#undef Gh
#undef RT
extern "C" void kernel_launch(void* const* d_in, const int* in_sizes, int n_in, void* d_out, int out_size, void* d_ws, size_t ws_size, hipStream_t stream) {
    static int grid = 0;
    if (grid == 0) {
        if (n_in != 29 || ws_size < WS_END) { fprintf(stderr, "kernel_launch: unexpected problem (n_in %d, ws %zu)\n", n_in, ws_size); grid = -1; return; }
        int dev = 0, cus = 0, per_cu = 0;
        hipGetDevice(&dev); hipDeviceGetAttribute(&cus, hipDeviceAttributeMultiprocessorCount, dev);
        hipFuncSetAttribute((const void*)fwd_kernel, hipFuncAttributeMaxDynamicSharedMemorySize, LDS_BYTES);
        if (hipOccupancyMaxActiveBlocksPerMultiprocessor(&per_cu, (const void*)fwd_kernel, 512, LDS_BYTES) != hipSuccess || per_cu < 1) per_cu = 1;
        (void)hipGetLastError();
        grid = cus * 1;
    }
    if (grid < 0) return;
    (void)hipMemsetAsync(d_ws, 0, 16384, stream);
    Args a{};
    for (int i = 0; i < 29; ++i) a.in[i] = (const float*)d_in[i];
    a.out = (float*)d_out; a.ws = (unsigned char*)d_ws;
    void* kargs[] = {&a};
    hipError_t e = hipLaunchCooperativeKernel((const void*)fwd_kernel, dim3(grid), dim3(512), kargs, LDS_BYTES, stream);
    if (e != hipSuccess) fprintf(stderr, "cooperative launch failed: %s (grid %d)\n", hipGetErrorString(e), grid);
}
```

```cpp
#include <hip/hip_runtime.h>
#include <hip/hip_cooperative_groups.h>
#include <cstdio>
#include <cstdint>
#include <cmath>
#include <type_traits>
namespace cg = cooperative_groups;

#define LAS __attribute__((address_space(3)))
#define GAS __attribute__((address_space(1)))
typedef unsigned short bf16_t;
typedef short bf16x8 __attribute__((ext_vector_type(8)));
typedef short s16x4 __attribute__((ext_vector_type(4)));
typedef float f32x4 __attribute__((ext_vector_type(4)));
typedef float f32x2 __attribute__((ext_vector_type(2)));
typedef float f32x16 __attribute__((ext_vector_type(16)));
typedef unsigned u32x4 __attribute__((ext_vector_type(4)));
typedef unsigned u32x2 __attribute__((ext_vector_type(2)));

constexpr int T = 98304, TP = 32768, SP = 16384, SS = 2048, DM = 1024, FF = 2816, NSEQ = 34;
constexpr float EPS = 1e-6f;
constexpr float LOG2E = 1.4426950408889634f;
constexpr size_t MiB = 1u << 20;
constexpr size_t WS_DC = 1 * MiB, WS_D1 = WS_DC + 262144, WS_D2 = WS_D1 + 131072, WS_TWP = WS_D2 + 131072, WS_TWS = WS_TWP + 131072;
constexpr size_t WS_ROPE = 2 * MiB, WS_MOD = 6 * MiB;
constexpr size_t WS_FNET = 10 * MiB, WS_SWAQKV = 14 * MiB, WS_SWAWO = 17 * MiB, WS_DIFFQKV = 19 * MiB, WS_DIFFWO = 25 * MiB;
constexpr size_t WS_GU = 27 * MiB, GU_STRIDE = (size_t)5632 * 1024 * 2, WS_DOWN = 71 * MiB, DOWN_STRIDE = (size_t)1024 * 2816 * 2;
constexpr size_t WS_HALO = 96 * MiB, WS_H = 130 * MiB, WS_BIG = 322 * MiB, WS_VT = 706 * MiB, WS_END = 898 * MiB;
static_assert(WS_GU + 4 * GU_STRIDE <= WS_DOWN && WS_DOWN + 4 * DOWN_STRIDE <= WS_HALO, "ws map");
static_assert(WS_HALO + (size_t)3072 * 2816 * 4 <= WS_H && WS_H + (size_t)T * 1024 * 2 <= WS_BIG && WS_BIG + (size_t)T * 2048 * 2 <= WS_VT, "ws map");
static_assert(WS_BIG + (size_t)T * FF * 2 <= WS_END && WS_VT + (size_t)T * 1024 * 2 <= WS_END, "ws map");
constexpr int LDS_BYTES = 163840;

__device__ __forceinline__ unsigned cvt_pk_bf16(float lo, float hi) { unsigned r; asm volatile("v_cvt_pk_bf16_f32 %0, %1, %2" : "=v"(r) : "v"(lo), "v"(hi)); return r; }
__device__ __forceinline__ float bf2f(unsigned short b) { return __uint_as_float(((unsigned)b) << 16); }
__device__ __forceinline__ unsigned short f2bf(float f) { return (unsigned short)(cvt_pk_bf16(f, 0.f) & 0xffffu); }
__device__ __forceinline__ int seq_of(int row) { return row < TP ? (row >> 14) : 2 + ((row - TP) >> 11); }
__device__ __forceinline__ int pos_of(int row) { return row < TP ? (row & (SP - 1)) : ((row - TP) & (SS - 1)); }
template <int M> __device__ __forceinline__ float swz_xor(float v) { return __builtin_bit_cast(float, __builtin_amdgcn_ds_swizzle(__builtin_bit_cast(int, v), (M << 10) | 0x1f)); }
__device__ __forceinline__ float xor32_sum(float v) { auto rr = __builtin_amdgcn_permlane32_swap(__float_as_uint(v), __float_as_uint(v), false, false); return __uint_as_float(rr[0]) + __uint_as_float(rr[1]); }
__device__ __forceinline__ float xor32_max(float v) { auto rr = __builtin_amdgcn_permlane32_swap(__float_as_uint(v), __float_as_uint(v), false, false); return fmaxf(__uint_as_float(rr[0]), __uint_as_float(rr[1])); }
__device__ __forceinline__ float xor32_partner(float v, bool low_half) { auto rr = __builtin_amdgcn_permlane32_swap(__float_as_uint(v), __float_as_uint(v), false, false); return low_half ? __uint_as_float(rr[1]) : __uint_as_float(rr[0]); }
__device__ __forceinline__ float wave_sum(float v) {
    v += swz_xor<1>(v); v += swz_xor<2>(v); v += swz_xor<4>(v); v += swz_xor<8>(v); v += swz_xor<16>(v);
    return xor32_sum(v);
}

namespace pg8 {
constexpr int BM = 256, BK = 64, HALF = 128, HTB = HALF * BK * 2, STAGE_BYTES = 8 * HTB;
__host__ __device__ __forceinline__ int lds_byte(int r, int c) { const int st = (r >> 4) * 2 + (c >> 5), rr = r & 15, cc = c & 31, ob = rr * 64 + cc * 2; return st * 1024 + (ob ^ (((ob >> 9) & 1) << 5)); }
__host__ __device__ __forceinline__ void stage_rc(int b, int& R, int& C) { const int st = b / 1024, sb = b % 1024, swz = sb ^ (((sb >> 9) & 1) << 5); R = (st >> 1) * 16 + swz / 64; C = (st & 1) * 32 + (swz % 64) / 2; }
__host__ __device__ __forceinline__ int perm32(int rho) { const int n = rho >> 4, i = rho & 15; return 8 * (i >> 2) + 4 * n + (i & 3); }
struct Unit { int pm, pn, z; };
__device__ __forceinline__ void tile_of(int L, int nM, int nN, int& pm, int& pn) {
    const int nwg = nM * nN; int wgid = L;
    { const int q = nwg / 8, r = nwg % 8, xcd = wgid % 8, off = wgid / 8; wgid = (xcd < r ? xcd * (q + 1) : r * (q + 1) + (xcd - r) * q) + off; }
    const int nig = 8 * nN, gid = wgid / nig, fm = gid * 8, gsz = (nM - fm) < 8 ? (nM - fm) : 8;
    pm = fm + ((wgid % nig) % gsz); pn = (wgid % nig) / gsz;
}
template <class P>
__device__ __forceinline__ void gemm_phase(LAS unsigned char* lds, const P& p) {
    int tid = threadIdx.x; asm volatile("" : "+v"(tid));
    const int wid = __builtin_amdgcn_readfirstlane(tid >> 6), lane = tid & 63, wr = wid >> 2, wc = wid & 3, fr = lane & 15, fq = lane >> 4;
    const int K = p.K, nt = K / BK;
    unsigned voffA[2], voffB[2];
#pragma unroll
    for (int i = 0; i < 2; ++i) { int R, C; stage_rc(tid * 16 + i * 8192, R, C); const int Rb = (R & ~31) + perm32(R & 31);
        voffA[i] = p.a_rowoff(R) + (unsigned)C * 2u; voffB[i] = p.b_rowoff(Rb) + (unsigned)C * 2u; }
    const size_t kstep = (size_t)(BK * 2);
    const size_t hstepA = p.a_hstep(), hstepB = p.b_hstep();
    const unsigned ldsw = (unsigned)wid * 1024u;
    const int aoff = lds_byte(wr * 64 + fr, fq * 8), boff = lds_byte(wc * 32 + fr, fq * 8);
#define PG8_SA(b, h) (((b) * 2 + (h)) * HTB)
#define PG8_SB(b, h) ((4 + (b) * 2 + (h)) * HTB)
#define PG8_STAGE(bufoff, gbase, voff) do { _Pragma("unroll") for (int _i = 0; _i < 2; ++_i) \
        __builtin_amdgcn_global_load_lds((const unsigned*)((const char*)(gbase) + (voff)[_i]), (LAS unsigned*)(lds + (bufoff) + ldsw + _i * 8192), 16, 0, 0); } while (0)
#define PG8_LDA(dst, b, h) do { _Pragma("unroll") for (int m = 0; m < 4; ++m) _Pragma("unroll") for (int k = 0; k < 2; ++k) dst[m][k] = *(const LAS bf16x8*)(lds + PG8_SA(b, h) + aoff + m * 2048 + k * 1024); } while (0)
#define PG8_LDB(dst, b, h) do { _Pragma("unroll") for (int n = 0; n < 2; ++n) _Pragma("unroll") for (int k = 0; k < 2; ++k) dst[n][k] = *(const LAS bf16x8*)(lds + PG8_SB(b, h) + boff + n * 2048 + k * 1024); } while (0)
#define PG8_MMA(ai, bj, At, Bt) do { __builtin_amdgcn_s_setprio(1); _Pragma("unroll") for (int m = 0; m < 4; ++m) _Pragma("unroll") for (int n = 0; n < 2; ++n) _Pragma("unroll") for (int k = 0; k < 2; ++k) \
        acc[ai][bj][m][n] = __builtin_amdgcn_mfma_f32_16x16x32_bf16(Bt[n][k], At[m][k], acc[ai][bj][m][n], 0, 0, 0); __builtin_amdgcn_s_setprio(0); } while (0)
#define PG8_WAIT_V(n) asm volatile("s_waitcnt vmcnt(" #n ")" ::: "memory")
#define PG8_WAIT_L(n) asm volatile("s_waitcnt lgkmcnt(" #n ")" ::: "memory")
#define PG8_BAR __builtin_amdgcn_s_barrier()
#define PG8_SCHED __builtin_amdgcn_sched_barrier(0)
    Unit cur, nxt; int ui = 0;
    if (!p.next(0, cur)) return;
    f32x4 acc[2][2][4][2];
#pragma unroll
    for (int a = 0; a < 2; ++a)
#pragma unroll
        for (int b = 0; b < 2; ++b)
#pragma unroll
            for (int m = 0; m < 4; ++m)
#pragma unroll
                for (int n = 0; n < 2; ++n) acc[a][b][m][n] = (f32x4){0.f, 0.f, 0.f, 0.f};
    bf16x8 At[4][2], B0[2][2], B1[2][2];
    const char* cA = p.a_base(cur); const char* cB = p.b_base(cur);
    PG8_STAGE(PG8_SB(0, 0), cB, voffB); PG8_STAGE(PG8_SB(0, 1), cB + hstepB, voffB); PG8_STAGE(PG8_SA(0, 0), cA, voffA); PG8_STAGE(PG8_SA(0, 1), cA + hstepA, voffA);
    if (wr == 1) PG8_BAR;
    PG8_WAIT_V(2); PG8_BAR;
    PG8_STAGE(PG8_SB(1, 0), cB + kstep, voffB); PG8_STAGE(PG8_SA(1, 0), cA + kstep, voffA); PG8_STAGE(PG8_SB(1, 1), cB + hstepB + kstep, voffB);
    PG8_WAIT_V(6); PG8_BAR;
    for (;;) {
        const bool has_next = p.next(ui + 1, nxt);
        const char* nA = has_next ? p.a_base(nxt) : cA; const char* nB = has_next ? p.b_base(nxt) : cB;
        for (int t = 0; t < nt; t += 2) {
            const bool last = (t == nt - 2);
            const char* a1 = cA + (size_t)(t + 1) * kstep;
            const char* a2 = last ? nA : cA + (size_t)(t + 2) * kstep; const char* b2 = last ? nB : cB + (size_t)(t + 2) * kstep;
            const char* a3 = a2 + kstep; const char* b3 = b2 + kstep;
            PG8_LDB(B0, 0, 0); PG8_LDB(B1, 0, 1); PG8_SCHED; PG8_LDA(At, 0, 0); PG8_STAGE(PG8_SA(1, 1), a1 + hstepA, voffA);
            PG8_WAIT_V(8); PG8_WAIT_L(0); PG8_BAR; PG8_MMA(0, 0, At, B0); PG8_MMA(0, 1, At, B1); PG8_BAR; PG8_SCHED;
            PG8_LDA(At, 0, 1); PG8_STAGE(PG8_SB(0, 0), b2, voffB); PG8_STAGE(PG8_SB(0, 1), b2 + hstepB, voffB); PG8_STAGE(PG8_SA(0, 0), a2, voffA);
            PG8_WAIT_V(8); PG8_WAIT_L(0); PG8_BAR; PG8_MMA(1, 0, At, B0); PG8_MMA(1, 1, At, B1); PG8_BAR; PG8_SCHED;
            PG8_LDB(B0, 1, 0); PG8_LDB(B1, 1, 1); PG8_SCHED; PG8_LDA(At, 1, 0); PG8_STAGE(PG8_SA(0, 1), a2 + hstepA, voffA);
            PG8_WAIT_V(8); PG8_WAIT_L(0); PG8_BAR; PG8_MMA(0, 0, At, B0); PG8_MMA(0, 1, At, B1); PG8_BAR; PG8_SCHED;
            PG8_LDA(At, 1, 1); PG8_STAGE(PG8_SB(1, 0), b3, voffB); PG8_STAGE(PG8_SB(1, 1), b3 + hstepB, voffB); PG8_STAGE(PG8_SA(1, 0), a3, voffA);
            PG8_WAIT_V(8); PG8_WAIT_L(0); PG8_BAR; PG8_MMA(1, 0, At, B0); PG8_MMA(1, 1, At, B1); PG8_BAR; PG8_SCHED;
        }
        if (wr == 0) PG8_BAR;
        { int fr_ = fr, fq_ = fq; asm volatile("" : "+v"(fr_), "+v"(fq_)); p.epi(acc, cur, wr, wc, fr_, fq_); }
        if (!has_next) break;
#pragma unroll
        for (int a = 0; a < 2; ++a)
#pragma unroll
            for (int b = 0; b < 2; ++b)
#pragma unroll
                for (int m = 0; m < 4; ++m)
#pragma unroll
                    for (int n = 0; n < 2; ++n) acc[a][b][m][n] = (f32x4){0.f, 0.f, 0.f, 0.f};
        cur = nxt; cA = nA; cB = nB; ++ui;
        if (wr == 1) PG8_BAR;
    }
    PG8_WAIT_V(0);
    PG8_BAR;
#undef PG8_SA
#undef PG8_SB
#undef PG8_STAGE
#undef PG8_LDA
#undef PG8_LDB
#undef PG8_MMA
#undef PG8_WAIT_V
#undef PG8_WAIT_L
#undef PG8_BAR
#undef PG8_SCHED
}
typedef f32x4 Acc[2][2][4][2];
__device__ __forceinline__ void store_tile_bf16(Acc& acc, bf16_t* base, size_t ldc, int wr, int wc, int fr, int fq) {
#pragma unroll
    for (int ai = 0; ai < 2; ++ai)
#pragma unroll
        for (int m = 0; m < 4; ++m) { bf16_t* rowp = base + (size_t)(ai * HALF + wr * 64 + m * 16 + fr) * ldc + wc * 32 + 8 * fq;
#pragma unroll
            for (int bj = 0; bj < 2; ++bj) { const f32x4 v0 = acc[ai][bj][m][0], v1 = acc[ai][bj][m][1]; u32x4 w;
                w.x = cvt_pk_bf16(v0[0], v0[1]); w.y = cvt_pk_bf16(v0[2], v0[3]); w.z = cvt_pk_bf16(v1[0], v1[1]); w.w = cvt_pk_bf16(v1[2], v1[3]);
                *(u32x4*)(rowp + bj * HALF) = w; } }
}
}
using pg8::Unit; using pg8::Acc; using pg8::tile_of;

struct ProbQKV {
    int K; const char* H; const char* W; int nqk, nv; bf16_t* QKout; int ldq; bf16_t* VTout; int G, c;
    __device__ __forceinline__ unsigned a_rowoff(int R) const { return (unsigned)R * 2048u; }
    __device__ __forceinline__ unsigned b_rowoff(int R) const { return (unsigned)R * 2048u; }
    __device__ __forceinline__ size_t a_hstep() const { return (size_t)128 * 2048; }
    __device__ __forceinline__ size_t b_hstep() const { return (size_t)128 * 2048; }
    __device__ __forceinline__ bool next(int i, Unit& u) const { long L = (long)i * G + c; const int n0 = 384 * nqk, n1 = 384 * nv;
        if (L < n0) { u.z = 0; tile_of((int)L, 384, nqk, u.pm, u.pn); return true; } L -= n0;
        if (L < n1) { u.z = 1; tile_of((int)L, nv, 384, u.pm, u.pn); return true; } return false; }
    __device__ __forceinline__ const char* a_base(const Unit& u) const { return u.z == 0 ? H + (size_t)u.pm * 256 * 2048 : W + (size_t)(nqk * 256 + u.pm * 256) * 2048; }
    __device__ __forceinline__ const char* b_base(const Unit& u) const { return u.z == 0 ? W + (size_t)u.pn * 256 * 2048 : H + (size_t)u.pn * 256 * 2048; }
    __device__ __forceinline__ void epi(Acc& acc, const Unit& u, int wr, int wc, int fr, int fq) const {
        bf16_t* base; size_t ldc;
        if (u.z == 0) { ldc = (size_t)ldq; base = QKout + (size_t)u.pm * 256 * ldc + u.pn * 256; } else { ldc = (size_t)T; base = VTout + (size_t)u.pm * 256 * ldc + u.pn * 256; }
        pg8::store_tile_bf16(acc, base, ldc, wr, wc, fr, fq);
    }
};
struct ProbResid {
    int K; const char* A; unsigned a_pitch; const char* W; const float* xin0; const float* xin1; float* out; const float* gate; const float* bias; int G, c;
    __device__ __forceinline__ unsigned a_rowoff(int R) const { return (unsigned)R * a_pitch; }
    __device__ __forceinline__ unsigned b_rowoff(int R) const { return (unsigned)R * (unsigned)(K * 2); }
    __device__ __forceinline__ size_t a_hstep() const { return (size_t)128 * a_pitch; }
    __device__ __forceinline__ size_t b_hstep() const { return (size_t)128 * K * 2; }
    __device__ __forceinline__ bool next(int i, Unit& u) const { const long L = (long)i * G + c; if (L >= 1536) return false; u.z = 0; tile_of((int)L, 384, 4, u.pm, u.pn); return true; }
    __device__ __forceinline__ const char* a_base(const Unit& u) const { return A + (size_t)u.pm * 256 * a_pitch; }
    __device__ __forceinline__ const char* b_base(const Unit& u) const { return W + (size_t)u.pn * 256 * K * 2; }
    __device__ __forceinline__ void epi(Acc& acc, const Unit& u, int wr, int wc, int fr, int fq) const {
        const int row0 = u.pm * 256; const float* gp = gate + (size_t)seq_of(row0) * 6144;
#pragma unroll
        for (int bj = 0; bj < 2; ++bj) { const int col = u.pn * 256 + bj * 128 + wc * 32 + 8 * fq;
            const f32x4 g0 = *(const f32x4*)(gp + col), g1 = *(const f32x4*)(gp + col + 4);
            f32x4 b0 = (f32x4){0.f, 0.f, 0.f, 0.f}, b1 = b0; if (bias) { b0 = *(const f32x4*)(bias + col); b1 = *(const f32x4*)(bias + col + 4); }
#pragma unroll
            for (int ai = 0; ai < 2; ++ai)
#pragma unroll
                for (int m = 0; m < 4; ++m) { const int row = row0 + ai * 128 + wr * 64 + m * 16 + fr;
                    const float* xs = (row < TP ? xin0 + (size_t)row * 1024 : xin1 + (size_t)(row - TP) * 1024) + col;
                    const f32x4 x0 = *(const f32x4*)xs, x1 = *(const f32x4*)(xs + 4);
                    float* op = out + (size_t)row * 1024 + col;
                    *(f32x4*)op = x0 + g0 * (acc[ai][bj][m][0] + b0); *(f32x4*)(op + 4) = x1 + g1 * (acc[ai][bj][m][1] + b1); } }
    }
};
struct ProbHalo {
    int K; const char* H; const char* W; float* Gh; int G, c;
    __device__ __forceinline__ unsigned a_rowoff(int R) const { return (unsigned)(64 * (R >> 1) + 63 * (R & 1)) * 2048u; }
    __device__ __forceinline__ unsigned b_rowoff(int R) const { return (unsigned)R * 2048u; }
    __device__ __forceinline__ size_t a_hstep() const { return (size_t)4096 * 2048; }
    __device__ __forceinline__ size_t b_hstep() const { return (size_t)256 * 2048; }
    __device__ __forceinline__ bool next(int i, Unit& u) const { const long L = (long)i * G + c; if (L >= 132) return false; u.z = 0; u.pm = (int)(L % 12); u.pn = (int)(L / 12); return true; }
    __device__ __forceinline__ const char* a_base(const Unit& u) const { return H + (size_t)u.pm * 8192 * 2048; }
    __device__ __forceinline__ const char* b_base(const Unit& u) const { return W + (size_t)u.pn * 512 * 2048; }
    __device__ __forceinline__ void epi(Acc& acc, const Unit& u, int wr, int wc, int fr, int fq) const {
#pragma unroll
        for (int ai = 0; ai < 2; ++ai)
#pragma unroll
            for (int m = 0; m < 4; ++m) { float* rp = Gh + (size_t)(u.pm * 256 + ai * 128 + wr * 64 + m * 16 + fr) * FF + u.pn * 256 + wc * 32 + 8 * fq;
#pragma unroll
                for (int bj = 0; bj < 2; ++bj) { *(f32x4*)(rp + bj * 128) = acc[ai][bj][m][0]; *(f32x4*)(rp + bj * 128 + 4) = acc[ai][bj][m][1]; } }
    }
};
struct ProbGateUp {
    int K; const char* H; const char* W; const float* Gh; const float* cw; const float* cb; bf16_t* act; int G, c;
    __device__ __forceinline__ unsigned a_rowoff(int R) const { return (unsigned)R * 2048u; }
    __device__ __forceinline__ unsigned b_rowoff(int R) const { return (unsigned)R * 2048u; }
    __device__ __forceinline__ size_t a_hstep() const { return (size_t)128 * 2048; }
    __device__ __forceinline__ size_t b_hstep() const { return (size_t)128 * 2048; }
    __device__ __forceinline__ bool next(int i, Unit& u) const { const long L = (long)i * G + c; if (L >= 384 * 22) return false; u.z = 0; tile_of((int)L, 384, 22, u.pm, u.pn); return true; }
    __device__ __forceinline__ const char* a_base(const Unit& u) const { return H + (size_t)u.pm * 256 * 2048; }
    __device__ __forceinline__ const char* b_base(const Unit& u) const { return W + (size_t)u.pn * 256 * 2048; }
    __device__ __forceinline__ void epi(Acc& acc, const Unit& u, int wr, int wc, int fr, int fq) const {
        const int lane = threadIdx.x & 63;
        const int colb = u.pn * 128 + wc * 32 + 8 * fq;
        float w0[8], w1[8], w2[8], bb[8];
#pragma unroll
        for (int q = 0; q < 2; ++q) { const f32x4 a = *(const f32x4*)(cw + colb + 4 * q), b = *(const f32x4*)(cw + FF + colb + 4 * q), cc = *(const f32x4*)(cw + 2 * FF + colb + 4 * q), d = *(const f32x4*)(cb + colb + 4 * q);
#pragma unroll
            for (int j = 0; j < 4; ++j) { w0[4 * q + j] = a[j]; w1[4 * q + j] = b[j]; w2[4 * q + j] = cc[j]; bb[4 * q + j] = d[j]; } }
        const int src_up = (fr == 0) ? lane + 15 : lane - 1, src_dn = (fr == 15) ? lane - 15 : lane + 1;
#pragma unroll
        for (int ai = 0; ai < 2; ++ai) {
            const int blk = u.pm * 4 + ai * 2 + wr;
            const bool first = blk < 512 ? ((blk & 255) == 0) : (((blk - 512) & 31) == 0);
            const bool lastb = blk < 512 ? ((blk & 255) == 255) : (((blk - 512) & 31) == 31);
            float hp[8], hn[8];
#pragma unroll
            for (int q = 0; q < 2; ++q) { f32x4 a = (f32x4){0.f, 0.f, 0.f, 0.f}, b = a;
                if (!first) a = *(const f32x4*)(Gh + (size_t)(2 * (blk - 1) + 1) * FF + colb + 4 * q);
                if (!lastb) b = *(const f32x4*)(Gh + (size_t)(2 * (blk + 1)) * FF + colb + 4 * q);
#pragma unroll
                for (int j = 0; j < 4; ++j) { hp[4 * q + j] = a[j]; hn[4 * q + j] = b[j]; } }
#pragma unroll
            for (int n = 0; n < 2; ++n)
#pragma unroll
                for (int j = 0; j < 4; ++j) { const int cidx = 4 * n + j; float rup[4], rdn[4];
#pragma unroll
                    for (int m = 0; m < 4; ++m) { const float gv = acc[ai][0][m][n][j]; rup[m] = __builtin_bit_cast(float, __builtin_amdgcn_ds_bpermute(src_up << 2, __builtin_bit_cast(int, gv))); rdn[m] = __builtin_bit_cast(float, __builtin_amdgcn_ds_bpermute(src_dn << 2, __builtin_bit_cast(int, gv))); }
#pragma unroll
                    for (int m = 0; m < 4; ++m) {
                        const float prev = (fr == 0) ? (m == 0 ? hp[cidx] : rup[m == 0 ? 0 : m - 1]) : rup[m];
                        const float nextv = (fr == 15) ? (m == 3 ? hn[cidx] : rdn[m == 3 ? 3 : m + 1]) : rdn[m];
                        const float cv = w0[cidx] * prev + w1[cidx] * acc[ai][0][m][n][j] + w2[cidx] * nextv + bb[cidx];
                        const float sg = __builtin_amdgcn_rcpf(1.0f + __expf(-cv));
                        acc[ai][0][m][n][j] = cv * sg * acc[ai][1][m][n][j]; } }
#pragma unroll
            for (int m = 0; m < 4; ++m) { const int row = u.pm * 256 + ai * 128 + wr * 64 + m * 16 + fr; const f32x4 v0 = acc[ai][0][m][0], v1 = acc[ai][0][m][1]; u32x4 w;
                w.x = cvt_pk_bf16(v0[0], v0[1]); w.y = cvt_pk_bf16(v0[2], v0[3]); w.z = cvt_pk_bf16(v1[0], v1[1]); w.w = cvt_pk_bf16(v1[2], v1[3]);
                *(u32x4*)(act + (size_t)row * FF + colb) = w; }
        }
    }
};
struct ProbF0 {
    int K; const char* Dc; const char* H; bf16_t* ZT; int part; int G, c;
    __device__ __forceinline__ unsigned a_rowoff(int R) const { return (unsigned)R * 512u; }
    __device__ __forceinline__ unsigned b_rowoff(int R) const { return (unsigned)R * (part == 0 ? 128u * 2048u : 16u * 2048u); }
    __device__ __forceinline__ size_t a_hstep() const { return (size_t)128 * 512; }
    __device__ __forceinline__ size_t b_hstep() const { return (size_t)2048; }
    __device__ __forceinline__ bool next(int i, Unit& u) const { const long L = (long)i * G + c; const int nct = part == 0 ? 128 : 256; if (L >= 8 * nct) return false;
        u.pn = (int)(L / 8); u.pm = (int)(L & 1); u.z = (int)((L >> 1) & 3); return true; }
    __device__ __forceinline__ const char* a_base(const Unit& u) const { return Dc + (size_t)u.pm * 256 * 512; }
    __device__ __forceinline__ const char* b_base(const Unit& u) const {
        const int ct = u.pn; const int tok = part == 0 ? (ct >> 6) * SP + 2 * (ct & 63) : TP + (ct >> 3) * SS + 2 * (ct & 7);
        return H + (size_t)tok * 2048 + u.z * 512; }
    __device__ __forceinline__ void epi(Acc& acc, const Unit& u, int wr, int wc, int fr, int fq) const {
        const int jb0 = (part == 0 ? 0 : 256) + 2 * u.pn;
#pragma unroll
        for (int ai = 0; ai < 2; ++ai)
#pragma unroll
            for (int m = 0; m < 4; ++m) { const int kc = ai * 128 + wr * 64 + m * 16 + fr; bf16_t* rp = ZT + (size_t)(u.z * 256 + kc) * (2 * T) + u.pm * 128 + wc * 32 + 8 * fq;
#pragma unroll
                for (int bj = 0; bj < 2; ++bj) { const f32x4 v0 = acc[ai][bj][m][0], v1 = acc[ai][bj][m][1]; u32x4 w;
                    w.x = cvt_pk_bf16(v0[0], v0[1]); w.y = cvt_pk_bf16(v0[2], v0[3]); w.z = cvt_pk_bf16(v1[0], v1[1]); w.w = cvt_pk_bf16(v1[2], v1[3]);
                    *(u32x4*)(rp + (size_t)(jb0 + bj) * 256) = w; } }
    }
};
struct ProbF1 {
    int K; const char* D1; bf16_t* ZT; const f32x2* TWp; const f32x2* TWs; int G, c;
    __device__ __forceinline__ unsigned a_rowoff(int R) const { return (unsigned)R * 512u; }
    __device__ __forceinline__ unsigned b_rowoff(int R) const { return (unsigned)R * 512u; }
    __device__ __forceinline__ size_t a_hstep() const { return (size_t)128 * 512; }
    __device__ __forceinline__ size_t b_hstep() const { return (size_t)128 * 512; }
    __device__ __forceinline__ bool next(int i, Unit& u) const { const long L = (long)i * G + c; if (L >= 3072) return false; u.pm = 0; u.pn = (int)(L / 3); u.z = (int)(L % 3); return true; }
    __device__ __forceinline__ const char* a_base(const Unit&) const { return D1; }
    __device__ __forceinline__ const char* b_base(const Unit& u) const { return (const char*)ZT + ((size_t)u.pn * (2 * T) + (size_t)u.z * 65536) * 2; }
    __device__ __forceinline__ void epi(Acc& acc, const Unit& u, int wr, int wc, int fr, int fq) const {
        bf16_t* reg = ZT + (size_t)u.pn * (2 * T) + (size_t)u.z * 65536;
#pragma unroll
        for (int m = 0; m < 4; ++m) { const int k1 = wr * 64 + m * 16 + fr;
#pragma unroll
            for (int bj = 0; bj < 2; ++bj) {
                int n2b; size_t off; const f32x2* tw;
                if (u.z == 0) { n2b = wc * 32 + 8 * fq; tw = TWp + k1 * 128 + n2b; off = (size_t)((k1 * 2 + bj) * 2) * 128 + n2b; }
                else { n2b = 8 * (fq & 1); const int blo = 8 * bj + 2 * wc + (fq >> 1); tw = TWs + k1 * 16 + n2b; off = (size_t)((k1 * 16 + blo) * 2) * 16 + n2b; }
                const int ro_stride = (u.z == 0) ? 128 : 16;
                float re[8], im[8];
#pragma unroll
                for (int n = 0; n < 2; ++n)
#pragma unroll
                    for (int j = 0; j < 4; ++j) { const f32x2 t = tw[4 * n + j]; const float a = acc[0][bj][m][n][j], b = acc[1][bj][m][n][j];
                        re[4 * n + j] = a * t.x + b * t.y; im[4 * n + j] = b * t.x - a * t.y; }
                u32x4 wre, wim;
                wre.x = cvt_pk_bf16(re[0], re[1]); wre.y = cvt_pk_bf16(re[2], re[3]); wre.z = cvt_pk_bf16(re[4], re[5]); wre.w = cvt_pk_bf16(re[6], re[7]);
                wim.x = cvt_pk_bf16(im[0], im[1]); wim.y = cvt_pk_bf16(im[2], im[3]); wim.z = cvt_pk_bf16(im[4], im[5]); wim.w = cvt_pk_bf16(im[6], im[7]);
                *(u32x4*)(reg + off) = wre; *(u32x4*)(reg + off + ro_stride) = wim; asm volatile("" ::: "memory"); } }
    }
};
struct ProbF2p {
    int K; const char* D2; const char* ZT; bf16_t* F; int G, c;
    __device__ __forceinline__ unsigned a_rowoff(int R) const { return (unsigned)R * 512u; }
    __device__ __forceinline__ unsigned b_rowoff(int R) const { return (unsigned)R * (unsigned)(2 * T * 2); }
    __device__ __forceinline__ size_t a_hstep() const { return (size_t)128 * 512; }
    __device__ __forceinline__ size_t b_hstep() const { return (size_t)128 * (2 * T * 2); }
    __device__ __forceinline__ bool next(int i, Unit& u) const { const long L = (long)i * G + c; if (L >= 1024) return false; u.pm = 0; u.pn = (int)(L >> 2); u.z = (int)(L & 3); return true; }
    __device__ __forceinline__ const char* a_base(const Unit&) const { return D2; }
    __device__ __forceinline__ const char* b_base(const Unit& u) const { return ZT + (size_t)u.z * 256 * (2 * T * 2) + (size_t)u.pn * 512; }
    __device__ __forceinline__ void epi(Acc& acc, const Unit& u, int wr, int wc, int fr, int fq) const {
        const int k1 = u.pn >> 1, b = u.pn & 1;
#pragma unroll
        for (int m = 0; m < 4; ++m) { const int k2 = wr * 64 + m * 16 + fr; bf16_t* rp = F + (size_t)(b * SP + k1 + 128 * k2) * 1024 + u.z * 256 + wc * 32 + 8 * fq;
#pragma unroll
            for (int bj = 0; bj < 2; ++bj) { const f32x4 v0 = acc[0][bj][m][0], v1 = acc[0][bj][m][1]; u32x4 w;
                w.x = cvt_pk_bf16(v0[0], v0[1]); w.y = cvt_pk_bf16(v0[2], v0[3]); w.z = cvt_pk_bf16(v1[0], v1[1]); w.w = cvt_pk_bf16(v1[2], v1[3]);
                *(u32x4*)(rp + bj * 128) = w; } }
    }
};

__device__ __forceinline__ int crow(int r, int hi) { return (r & 3) + 8 * (r >> 2) + 4 * hi; }
struct AttnArgs {
    const bf16_t* QK; int ldq;
    const bf16_t* VT;
    bf16_t* O;
    int seq0, S, qpos0;
    int qcol0, kcol, vrow0, ocol0;
    int kt_lo, kt_hi;
    float sink2a, sink2b;
    float lam, post;
    const float* subg;
};
template <int MODE, bool TRACK>
__device__ __forceinline__ void attn_unit(unsigned char* lds, const AttnArgs& a) {
    constexpr int KW = MODE == 0 ? 64 : 128, DV = MODE == 0 ? 64 : 128, NDB = DV / 32, KPB = (KW + 8) * 2, VPB = 144, NLD = MODE == 0 ? 1 : 2;
    constexpr int KBUF = 64 * KPB, VBUF = DV * VPB;
    int tid = threadIdx.x; asm volatile("" : "+v"(tid));
    const int lane = tid & 63, r32 = lane & 31, hi = lane >> 5; const int wid = __builtin_amdgcn_readfirstlane(tid >> 6), wg = wid >> 2, wq = wid & 3;
    const int qrow = a.seq0 + a.qpos0 + wq * 32 + r32;
    bf16x8 qr[4];
    { const bf16_t* qp = a.QK + (size_t)qrow * a.ldq + a.qcol0 + wg * 64 + hi * 8;
#pragma unroll
      for (int d0 = 0; d0 < 4; ++d0) qr[d0] = *(const bf16x8*)(qp + d0 * 16); }
    const int coff = MODE == 0 ? 0 : wg * 64;
    const int qi = a.qpos0 + wq * 32 + r32;
    f32x16 o[NDB];
#pragma unroll
    for (int i = 0; i < NDB; ++i)
#pragma unroll
        for (int r = 0; r < 16; ++r) o[i][r] = 0.f;
    float mref = TRACK ? -1e30f : 0.f, lrun = 0.f;
    u32x4 kreg[NLD], vreg[NLD];
    const int NT = a.kt_hi - a.kt_lo;
    const unsigned koff = (unsigned)(((MODE == 0 ? tid >> 3 : tid >> 4) * a.ldq + (MODE == 0 ? tid & 7 : tid & 15) * 8) * 2);
    const unsigned voff = (unsigned)(((tid >> 3) * T + (tid & 7) * 8) * 2);
    auto gload_k = [&](int kt) {
        const char* kb = (const char*)a.QK + ((size_t)(a.seq0 + kt * 64) * a.ldq + a.kcol) * 2;
#pragma unroll
        for (int i = 0; i < NLD; ++i) kreg[i] = *(const u32x4*)(kb + (size_t)i * 32 * a.ldq * 2 + koff); };
    auto gload_v = [&](int kt) {
        const char* vb = (const char*)a.VT + ((size_t)a.vrow0 * T + a.seq0 + kt * 64) * 2;
#pragma unroll
        for (int i = 0; i < NLD; ++i) vreg[i] = *(const u32x4*)(vb + (size_t)i * 64 * T * 2 + voff); };
    auto st_k = [&](int buf) {
#pragma unroll
        for (int i = 0; i < NLD; ++i) { const int idx = tid + 512 * i; const int key = MODE == 0 ? idx >> 3 : idx >> 4, ch = MODE == 0 ? idx & 7 : idx & 15;
            *(u32x4*)(lds + buf * KBUF + key * KPB + ch * 16) = kreg[i]; } };
    auto st_v = [&](int buf) {
#pragma unroll
        for (int i = 0; i < NLD; ++i) { const int idx = tid + 512 * i; const int d = idx >> 3, ch = idx & 7;
            unsigned char* dp = lds + 2 * KBUF + buf * VBUF + d * VPB + (ch >> 1) * 32 + (ch & 1) * 8; *(u32x2*)dp = (u32x2){vreg[i].x, vreg[i].y}; *(u32x2*)(dp + 16) = (u32x2){vreg[i].z, vreg[i].w}; } };
    auto stepf = [&](int t, auto HASQK_, auto HASPV_, f32x16 (&p)[2], f32x16 (&s)[2]) {
        constexpr bool HASQK = decltype(HASQK_)::value, HASPV = decltype(HASPV_)::value;
        if (t + 1 < NT) gload_k(a.kt_lo + t + 1);
        if (t < NT) gload_v(a.kt_lo + t);
        const unsigned char* Ks = lds + (t & 1) * KBUF + r32 * KPB + (coff + 8 * hi) * 2;
        const unsigned char* Vs = lds + 2 * KBUF + ((t + 1) & 1) * VBUF + r32 * VPB + 16 * hi;
        const f32x16 zz = (f32x16){0.f, 0.f, 0.f, 0.f, 0.f, 0.f, 0.f, 0.f, 0.f, 0.f, 0.f, 0.f, 0.f, 0.f, 0.f, 0.f};
        bf16x8 kf[8]; bf16x8 pk[2][2]; u32x4 pw[2][2];
        if (HASQK) {
#pragma unroll
            for (int j = 0; j < 3; ++j) kf[j] = *(const bf16x8*)(Ks + (j >> 2) * 32 * KPB + (j & 3) * 32);
        }
        float sum0 = 0.f, sum1 = 0.f;
#pragma unroll
        for (int j = 0; j < 8; ++j) {
            if (HASQK) { if (j + 3 < 8) kf[j + 3] = *(const bf16x8*)(Ks + ((j + 3) >> 2) * 32 * KPB + ((j + 3) & 3) * 32);
                s[j >> 2] = __builtin_amdgcn_mfma_f32_32x32x16_bf16(kf[j], qr[j & 3], (j & 3) == 0 ? zz : s[j >> 2], 0, 0, 0); }
            if (HASPV) { const int kb = j >> 2, e = (4 * j) & 15;
                sum0 += p[kb][e] + p[kb][e + 2]; sum1 += p[kb][e + 1] + p[kb][e + 3];
                const unsigned w0 = cvt_pk_bf16(p[kb][e], p[kb][e + 1]), w1 = cvt_pk_bf16(p[kb][e + 2], p[kb][e + 3]);
                if ((j & 1) == 0) { pw[kb][(j >> 1) & 1].x = w0; pw[kb][(j >> 1) & 1].y = w1; } else { pw[kb][(j >> 1) & 1].z = w0; pw[kb][(j >> 1) & 1].w = w1; } }
            __builtin_amdgcn_sched_barrier(0);
        }
        if (HASPV) { lrun += sum0 + sum1;
#pragma unroll
            for (int kb = 0; kb < 2; ++kb)
#pragma unroll
                for (int kg = 0; kg < 2; ++kg) pk[kb][kg] = __builtin_bit_cast(bf16x8, pw[kb][kg]); }
        bool resc = false; float alpha = 1.f;
        if (HASQK) {
            if (MODE == 0) { const int kp0 = (a.kt_lo + t) * 64;
#pragma unroll
                for (int kb = 0; kb < 2; ++kb)
#pragma unroll
                    for (int r = 0; r < 16; ++r) { const int dlt = qi - (kp0 + 32 * kb + crow(r, hi)); if (dlt > 128 || dlt < -128) s[kb][r] = -INFINITY; } }
            if (TRACK) {
            float m0 = fmaxf(fmaxf(s[0][0], s[0][1]), s[1][0]), m1 = fmaxf(fmaxf(s[0][2], s[0][3]), s[1][1]); m0 = fmaxf(fmaxf(m0, s[1][2]), s[1][3]);
#pragma unroll
            for (int r = 4; r < 16; r += 4) { m0 = fmaxf(fmaxf(m0, s[0][r]), s[0][r + 1]); m1 = fmaxf(fmaxf(m1, s[0][r + 2]), s[0][r + 3]); m0 = fmaxf(fmaxf(m0, s[1][r]), s[1][r + 1]); m1 = fmaxf(fmaxf(m1, s[1][r + 2]), s[1][r + 3]); }
            float rm = xor32_max(fmaxf(m0, m1));
            resc = __any(rm - mref > 8.0f);
            if (resc) { const float mnew = fmaxf(mref, rm); alpha = __builtin_amdgcn_exp2f(mref - mnew); mref = mnew; }
            }
        }
        __builtin_amdgcn_sched_barrier(0);
        constexpr int NPV = 4 * NDB, EPG = 32 / NPV;
        if (HASPV) {
            bf16x8 vf[NPV];
            auto vread = [&](int jj) { const int i = jj >> 2, kb = (jj >> 1) & 1, kg = jj & 1; vf[jj] = *(const bf16x8*)(Vs + 32 * i * VPB + (32 * kb + 16 * kg) * 2); };
            vread(0); vread(1); vread(2);
#pragma unroll
            for (int jj = 0; jj < NPV; ++jj) {
                if (jj + 3 < NPV) vread(jj + 3);
                o[jj >> 2] = __builtin_amdgcn_mfma_f32_32x32x16_bf16(vf[jj], pk[(jj >> 1) & 1][jj & 1], o[jj >> 2], 0, 0, 0);
                if (HASQK) {
#pragma unroll
                    for (int q = 0; q < EPG; ++q) { const int e = jj * EPG + q; s[e >> 4][e & 15] = __builtin_amdgcn_exp2f(TRACK ? s[e >> 4][e & 15] - mref : s[e >> 4][e & 15]); }
                    asm volatile("" : "+v"(s[(jj * EPG) >> 4])); }
                __builtin_amdgcn_sched_barrier(0);
            }
        } else if (HASQK) {
#pragma unroll
            for (int e = 0; e < 32; ++e) s[e >> 4][e & 15] = __builtin_amdgcn_exp2f(TRACK ? s[e >> 4][e & 15] - mref : s[e >> 4][e & 15]);
        }
        if (resc) { lrun *= alpha;
#pragma unroll
            for (int i = 0; i < NDB; ++i)
#pragma unroll
                for (int r = 0; r < 16; ++r) o[i][r] *= alpha; }
        if (t + 1 < NT) st_k((t + 1) & 1);
        if (t < NT) st_v(t & 1);
        __syncthreads();
    };
    __syncthreads();
    gload_k(a.kt_lo); st_k(0);
    __syncthreads();
    f32x16 sA[2], sB[2];
    {
        const std::true_type TT{}; const std::false_type FF_{};
        stepf(0, TT, FF_, sB, sA);
        for (int t = 1; t < NT - 1; t += 2) { stepf(t, TT, TT, sA, sB); stepf(t + 1, TT, TT, sB, sA); }
        stepf(NT - 1, TT, TT, sA, sB);
        stepf(NT, FF_, TT, sB, sA);
    }
    const float ltot = xor32_sum(lrun);
    int t2 = tid; asm volatile("" : "+v"(t2));
    const int qrow_e = a.seq0 + a.qpos0 + ((t2 >> 6) & 3) * 32 + (t2 & 31);
    if (MODE == 0) {
        const float sk = wg == 0 ? a.sink2a : a.sink2b; const float mf = fmaxf(mref, sk), al = __builtin_amdgcn_exp2f(mref - mf);
        const float inv = al / (ltot * al + __builtin_amdgcn_exp2f(sk - mf));
        bf16_t* op = a.O + (size_t)qrow_e * 1024 + a.ocol0 + wg * 64 + 4 * hi;
#pragma unroll
        for (int i = 0; i < NDB; ++i)
#pragma unroll
            for (int rq = 0; rq < 4; ++rq) { u32x2 w; w.x = cvt_pk_bf16(o[i][4 * rq] * inv, o[i][4 * rq + 1] * inv); w.y = cvt_pk_bf16(o[i][4 * rq + 2] * inv, o[i][4 * rq + 3] * inv);
                *(u32x2*)(op + 32 * i + 8 * rq) = w; }
    } else {
        const float inv = 1.0f / ltot;
        float* X = (float*)lds;
        if (wg == 1) {
#pragma unroll
            for (int i = 0; i < NDB; ++i)
#pragma unroll
                for (int rq = 0; rq < 4; ++rq) *(f32x4*)(X + (wq * 32 + r32) * 132 + 32 * i + 8 * rq + 4 * hi) = (f32x4){o[i][4 * rq] * inv, o[i][4 * rq + 1] * inv, o[i][4 * rq + 2] * inv, o[i][4 * rq + 3] * inv};
        }
        __syncthreads();
        if (wg == 0) {
            float ss = 0.f;
#pragma unroll
            for (int i = 0; i < NDB; ++i)
#pragma unroll
                for (int rq = 0; rq < 4; ++rq) { const f32x4 x1 = *(const f32x4*)(X + (wq * 32 + r32) * 132 + 32 * i + 8 * rq + 4 * hi);
#pragma unroll
                    for (int j = 0; j < 4; ++j) { const float v = o[i][4 * rq + j] * inv - a.lam * x1[j]; o[i][4 * rq + j] = v; ss += v * v; } }
            ss = xor32_sum(ss);
            const float rs = rsqrtf(ss * (1.0f / 128.0f) + EPS) * a.post;
            bf16_t* op = a.O + (size_t)qrow_e * 1024 + a.ocol0 + 4 * hi;
#pragma unroll
            for (int i = 0; i < NDB; ++i)
#pragma unroll
                for (int rq = 0; rq < 4; ++rq) { const f32x4 g = *(const f32x4*)(a.subg + 32 * i + 8 * rq + 4 * hi); u32x2 w;
                    w.x = cvt_pk_bf16(o[i][4 * rq] * rs * g[0], o[i][4 * rq + 1] * rs * g[1]); w.y = cvt_pk_bf16(o[i][4 * rq + 2] * rs * g[2], o[i][4 * rq + 3] * rs * g[3]);
                    *(u32x2*)(op + 32 * i + 8 * rq) = w; }
        }
    }
}

__device__ __forceinline__ void transpose_item(const float* W, int K, int N, bf16_t* WT, int mode, float* scr, int item, int lane) {
    const int nblk = N / 32, kb = item / nblk, nb = item % nblk, k0 = 64 * kb, n0 = 32 * nb;
    const int drow = mode == 0 ? n0 : ((n0 >> 7) * 256 + (n0 & 127) + (mode == 2 ? 128 : 0));
#pragma unroll 8
    for (int i = 0; i < 32; ++i) { const int kk = 2 * i + (lane >> 5); scr[kk * 33 + (lane & 31)] = W[(size_t)(k0 + kk) * N + n0 + (lane & 31)]; }
    __builtin_amdgcn_fence(__ATOMIC_ACQ_REL, "wavefront"); asm volatile("s_waitcnt lgkmcnt(0)" ::: "memory");
    const int cc = lane & 7;
#pragma unroll
    for (int j = 0; j < 4; ++j) { const int n = (lane >> 3) + 8 * j; const float* s = scr + (8 * cc) * 33 + n;
        u32x4 o; o.x = cvt_pk_bf16(s[0 * 33], s[1 * 33]); o.y = cvt_pk_bf16(s[2 * 33], s[3 * 33]); o.z = cvt_pk_bf16(s[4 * 33], s[5 * 33]); o.w = cvt_pk_bf16(s[6 * 33], s[7 * 33]);
        *(u32x4*)(WT + (size_t)(drow + n) * K + k0 + 8 * cc) = o; }
    asm volatile("s_waitcnt lgkmcnt(0)" ::: "memory"); __builtin_amdgcn_fence(__ATOMIC_ACQ_REL, "wavefront");
}
__device__ __forceinline__ void prep_phase(const float* x0, const float* x1, const float* g, const float* modl, int shc, int scc, bf16_t* Hh, int gw, int ngw, int lane) {
    asm volatile("" : "+v"(lane));
    for (int row = gw; row < T; row += ngw) {
        const float* xr = (row < TP ? x0 + (size_t)row * 1024 : x1 + (size_t)(row - TP) * 1024);
        const float* mp = modl + (size_t)seq_of(row) * 6144;
        f32x4 v[4]; float s = 0.f;
#pragma unroll
        for (int j = 0; j < 4; ++j) { v[j] = *(const f32x4*)(xr + 4 * lane + 256 * j); s += (v[j][0] * v[j][0] + v[j][1] * v[j][1]) + (v[j][2] * v[j][2] + v[j][3] * v[j][3]); }
        const float rs = rsqrtf(wave_sum(s) * (1.0f / 1024.0f) + EPS);
#pragma unroll
        for (int j = 0; j < 4; ++j) { const int cidx = 4 * lane + 256 * j; const f32x4 gg = *(const f32x4*)(g + cidx), sc = *(const f32x4*)(mp + scc * 1024 + cidx), sh = *(const f32x4*)(mp + shc * 1024 + cidx);
            const f32x4 y = v[j] * rs * gg * (sc + 1.0f) + sh; u32x2 w; w.x = cvt_pk_bf16(y[0], y[1]); w.y = cvt_pk_bf16(y[2], y[3]);
            *(u32x2*)(Hh + (size_t)row * 1024 + cidx) = w; }
    }
}
template <int NCH>
__device__ __forceinline__ void qkpost_phase(bf16_t* QK, int ldq, int nq_heads, int nheads, const float* qg, const float* kg, const f32x2* RT, int gw, int ngw, int lane) {
    asm volatile("" : "+v"(lane));
    const int j = lane & 7, hl = lane >> 3;
    float gq8[8], gk8[8];
#pragma unroll
    for (int e = 0; e < 8; ++e) { gq8[e] = qg[8 * j + e] * (0.125f * LOG2E); gk8[e] = kg[8 * j + e]; }
    for (int row = gw; row < T; row += ngw) {
        bf16_t* rp = QK + (size_t)row * ldq + lane * 8;
        u32x4 xin[NCH];
#pragma unroll
        for (int c = 0; c < NCH; ++c) if (c * 8 + hl < nheads) xin[c] = *(const u32x4*)(rp + c * 512);
        const f32x4* rt = (const f32x4*)(RT + (size_t)pos_of(row) * 32 + 8 * (j & 3));
        const f32x4 t0 = rt[0], t1 = rt[1], t2 = rt[2], t3 = rt[3];
        const float cs[8] = {t0[0], t0[2], t1[0], t1[2], t2[0], t2[2], t3[0], t3[2]}, sn[8] = {t0[1], t0[3], t1[1], t1[3], t2[1], t2[3], t3[1], t3[3]};
#pragma unroll
        for (int c = 0; c < NCH; ++c) {
            const int head = c * 8 + hl;
            float x[8];
#pragma unroll
            for (int e = 0; e < 4; ++e) { x[2 * e] = __uint_as_float(xin[c][e] << 16); x[2 * e + 1] = __uint_as_float(xin[c][e] & 0xffff0000u); }
            float ss = 0.f;
#pragma unroll
            for (int e = 0; e < 8; ++e) ss += x[e] * x[e];
            ss += swz_xor<1>(ss); ss += swz_xor<2>(ss); ss += swz_xor<4>(ss);
            const float rs = rsqrtf(ss * (1.0f / 64.0f) + EPS);
            float ov[8];
#pragma unroll
            for (int e = 0; e < 8; ++e) { const float y = x[e] * rs * (head < nq_heads ? gq8[e] : gk8[e]); const float pr = swz_xor<4>(y);
                ov[e] = j < 4 ? (y * cs[e] - pr * sn[e]) : (y * cs[e] + pr * sn[e]); }
            u32x4 w; w.x = cvt_pk_bf16(ov[0], ov[1]); w.y = cvt_pk_bf16(ov[2], ov[3]); w.z = cvt_pk_bf16(ov[4], ov[5]); w.w = cvt_pk_bf16(ov[6], ov[7]);
            if (head < nheads) *(u32x4*)(rp + c * 512) = w;
        }
    }
}

#define XB_TMO      128
#define XB_XCNT(j)  (256  + 64 * (j))
#define XB_XSUB(j)  (1280 + 64 * (j))
#define XB_XGEN(j)  (2304 + 64 * (j))
#define XB_TOP      3328
#define XB_TOPGEN   3392
#define XCD_BAR_WORDS 3456
#define XB_SPIN_CAP (1u << 22)
__device__ __forceinline__ unsigned xb_ld(unsigned* p)              { return __hip_atomic_load(p, __ATOMIC_RELAXED, __HIP_MEMORY_SCOPE_AGENT); }
__device__ __forceinline__ unsigned xb_add(unsigned* p, unsigned v) { return __hip_atomic_fetch_add(p, v, __ATOMIC_RELAXED, __HIP_MEMORY_SCOPE_AGENT); }
__device__ __forceinline__ unsigned xb_xcc_id() { return (unsigned)__builtin_amdgcn_s_getreg((3 << 11) | 20) & 0xFu; }
#define XB_SPIN(cond, bar) do { unsigned _sp = 0; while (cond) { __builtin_amdgcn_s_sleep(1); \
    if ((++_sp & 255u) == 0u) { if (xb_ld(&(bar)[XB_TMO])) break; if (_sp > XB_SPIN_CAP) { atomicAdd(&(bar)[XB_TMO], 1u); break; } } } } while (0)
struct XcdBarrier { unsigned* bar; unsigned x; volatile LAS unsigned* st; };
__device__ __forceinline__ XcdBarrier xcd_barrier_post(unsigned* bar, volatile LAS unsigned* st) {
    XcdBarrier b; b.bar = bar; b.x = xb_xcc_id(); b.st = st;
    if (threadIdx.x == 0) (void)xb_add(&bar[XB_XCNT(b.x)], 1u);
    return b;
}
__device__ __forceinline__ void xcd_barrier_complete(unsigned* bar, unsigned x, unsigned& nloc, unsigned& nx) {
    const unsigned G = gridDim.x * gridDim.y * gridDim.z;
    unsigned sum, cnt, mine, sp = 0u;
    for (;;) {
        sum = 0u; cnt = 0u; mine = 0u;
#pragma unroll
        for (unsigned j = 0; j < 16; ++j) { const unsigned c = xb_ld(&bar[XB_XCNT(j)]); sum += c; cnt += (c > 0u) ? 1u : 0u; mine = (j == x) ? c : mine; }
        if (sum == G) break;
        __builtin_amdgcn_s_sleep(1);
        if ((++sp & 255u) == 0u) { if (xb_ld(&bar[XB_TMO])) break; if (sp > XB_SPIN_CAP) { atomicAdd(&bar[XB_TMO], 1u); break; } }
    }
    nloc = mine > 0u ? mine : 1u; nx = cnt > 0u ? cnt : 1u;
}
__device__ __forceinline__ void xcd_barrier(const XcdBarrier& b) {
    asm volatile("s_waitcnt vmcnt(0)" ::: "memory");
    __syncthreads();
    if (threadIdx.x == 0) {
        unsigned* bar = b.bar;
        __builtin_amdgcn_s_waitcnt(0);
        unsigned nloc = b.st[0], nx = b.st[1];
        if (nloc == 0u) { xcd_barrier_complete(bar, b.x, nloc, nx); b.st[0] = nloc; b.st[1] = nx; }
        const unsigned old = xb_add(&bar[XB_XSUB(b.x)], 1u);
        const unsigned gen = old / nloc;
        if (old + 1u == (gen + 1u) * nloc) {
            __builtin_amdgcn_fence(__ATOMIC_RELEASE, "agent");
            asm volatile("s_waitcnt vmcnt(0)" ::: "memory");
            const unsigned og = xb_add(&bar[XB_TOP], 1u);
            const unsigned tg = og / nx;
            if (og + 1u == (tg + 1u) * nx) xb_add(&bar[XB_TOPGEN], 1u);
            else XB_SPIN(xb_ld(&bar[XB_TOPGEN]) == tg, bar);
            __builtin_amdgcn_fence(__ATOMIC_ACQUIRE, "agent");
            xb_add(&bar[XB_XGEN(b.x)], 1u);
            asm volatile("s_waitcnt vmcnt(0)" ::: "memory");
        } else {
            XB_SPIN(xb_ld(&bar[XB_XGEN(b.x)]) == gen, bar);
            __builtin_amdgcn_fence(__ATOMIC_ACQUIRE, "agent");
            asm volatile("s_waitcnt vmcnt(0)" ::: "memory");
        }
    }
    __syncthreads();
}

#ifndef PHASES
#define PHASES 0xFFFFFF
#endif
#define EN(b) ((PHASES >> (b)) & 1)
struct Args { const float* in[29]; float* out; unsigned char* ws; };

__global__ void __launch_bounds__(512, 2) fwd_kernel(Args args) {
    extern __shared__ __attribute__((aligned(16))) unsigned char lds[];
    cg::grid_group grid = cg::this_grid();
    const int tid = threadIdx.x, lane = tid & 63, wave = __builtin_amdgcn_readfirstlane(tid >> 6);
    const int G = gridDim.x, bx = blockIdx.x;
    const int vcu = (G % 8 == 0) ? (bx % 8) * (G / 8) + bx / 8 : bx;
    const int gw = vcu * 8 + wave, ngw = G * 8;
    __builtin_assume(gw >= 0 && gw < 8192 && ngw >= 8 && ngw <= 8192 && G >= 1 && G <= 1024);
    const __attribute__((address_space(4))) Args* ap = (const __attribute__((address_space(4))) Args*)__builtin_amdgcn_kernarg_segment_ptr();
    asm volatile("" : "+s"(ap));
    unsigned long long wsi = (unsigned long long)ap->ws, outi = (unsigned long long)ap->out;
#define ws ((unsigned char*)(GAS unsigned char*)wsi)
#define out ((float*)(GAS float*)outi)
#define INP(i) ((const float*)(const GAS float*)(ap->in[i]))
    LAS unsigned char* lds3 = (LAS unsigned char*)lds;
#define mod ((float*)(ws + WS_MOD))
#define Hh ((bf16_t*)(ws + WS_H))
#define BIG ((bf16_t*)(ws + WS_BIG))
#define VTB ((bf16_t*)(ws + WS_VT))
#define Gh ((float*)(ws + WS_HALO))
#define RT ((const f32x2*)(ws + WS_ROPE))
#define OPQ() asm volatile("" : "+s"(wsi), "+s"(outi), "+s"(ap))
    if (tid < 16) ((LAS unsigned*)(lds3 + LDS_BYTES - 64))[tid] = 0u;
    __syncthreads();
    XcdBarrier xbar = xcd_barrier_post((unsigned*)ws, (volatile LAS unsigned*)(lds3 + LDS_BYTES - 64));
#define GSYNC() do { xcd_barrier(xbar); OPQ(); } while (0)

    if (EN(0)) {
        float* cact = (float*)lds;
        for (int idx = tid; idx < NSEQ * 1024; idx += 512) { const int b = idx >> 10, k = idx & 1023; const float cv = b < 2 ? INP(2)[b * 1024 + k] : INP(3)[(b - 2) * 1024 + k];
            cact[idx] = cv * __builtin_amdgcn_rcpf(1.0f + __expf(-cv)); }
        __syncthreads();
        {
            float* red = (float*)(lds + NSEQ * 1024 * 4);
            for (int item = bx; item < 384; item += G) {
                const int li = item / 96, n = (item % 96) * 64 + lane;
                const float* wp = INP(4) + ((size_t)li * 1024 + (size_t)wave * 128) * 6144 + n;
                float acc[NSEQ];
#pragma unroll
                for (int b = 0; b < NSEQ; ++b) acc[b] = 0.f;
                for (int k4 = 0; k4 < 32; ++k4) {
                    const float w0 = wp[(size_t)(4 * k4) * 6144], w1 = wp[(size_t)(4 * k4 + 1) * 6144], w2 = wp[(size_t)(4 * k4 + 2) * 6144], w3 = wp[(size_t)(4 * k4 + 3) * 6144];
#pragma unroll
                    for (int b = 0; b < NSEQ; ++b) { const f32x4 cv = *(const f32x4*)(cact + b * 1024 + wave * 128 + 4 * k4); acc[b] += (cv[0] * w0 + cv[1] * w1) + (cv[2] * w2 + cv[3] * w3); }
                }
                for (int r = 0; r < 8; ++r) {
                    if (wave == r) {
#pragma unroll
                        for (int b = 0; b < NSEQ; ++b) red[b * 64 + lane] = (r == 0 ? 0.f : red[b * 64 + lane]) + acc[b];
                    }
                    __syncthreads();
                }
                if (wave == 0) { const float bias = INP(5)[li * 6144 + n];
#pragma unroll
                    for (int b = 0; b < NSEQ; ++b) mod[(size_t)(li * NSEQ + b) * 6144 + n] = red[b * 64 + lane] + bias; }
                __syncthreads();
            }
        }
        __syncthreads();
        float* scr = (float*)(lds + wave * 16384);
        for (int mi = 0; mi < 18; ++mi) {
            const float* W; int K, N, mode = 0; bf16_t* WT;
            if (mi < 2) { W = INP(8) + (size_t)mi * 1024 * 1024; K = 1024; N = 1024; WT = (bf16_t*)(ws + WS_FNET) + (size_t)mi * 1024 * 1024; }
            else if (mi == 2) { W = INP(10); K = 1024; N = 1536; WT = (bf16_t*)(ws + WS_SWAQKV); }
            else if (mi == 3) { W = INP(14); K = 1024; N = 1024; WT = (bf16_t*)(ws + WS_SWAWO); }
            else if (mi == 4) { W = INP(15); K = 1024; N = 3072; WT = (bf16_t*)(ws + WS_DIFFQKV); }
            else if (mi == 5) { W = INP(23); K = 1024; N = 1024; WT = (bf16_t*)(ws + WS_DIFFWO); }
            else if (mi < 10) { const int l = mi - 6; W = INP(24) + (size_t)l * 1024 * FF; K = 1024; N = FF; WT = (bf16_t*)(ws + WS_GU + l * GU_STRIDE); mode = 1; }
            else if (mi < 14) { const int l = mi - 10; W = INP(25) + (size_t)l * 1024 * FF; K = 1024; N = FF; WT = (bf16_t*)(ws + WS_GU + l * GU_STRIDE); mode = 2; }
            else { const int l = mi - 14; W = INP(28) + (size_t)l * FF * 1024; K = FF; N = 1024; WT = (bf16_t*)(ws + WS_DOWN + l * DOWN_STRIDE); }
            const int nitems = (K / 64) * (N / 32);
            for (int it = gw; it < nitems; it += ngw) transpose_item(W, K, N, WT, mode, scr, it, lane);
        }
        const int gt = vcu * 512 + tid, ngt = G * 512;
        bf16_t* Dc = (bf16_t*)(ws + WS_DC); bf16_t* D1 = (bf16_t*)(ws + WS_D1); bf16_t* D2 = (bf16_t*)(ws + WS_D2);
        f32x2* TWp = (f32x2*)(ws + WS_TWP); f32x2* TWs = (f32x2*)(ws + WS_TWS); f32x2* RTw = (f32x2*)(ws + WS_ROPE);
        for (int e = gt; e < 512 * 256; e += ngt) { const int r = e >> 8, cc = e & 255, ri = r >> 8, kc = r & 255; const float rev = (float)((cc * kc) & 255) * (1.0f / 256.0f);
            const float v = ri == 0 ? __builtin_amdgcn_cosf(rev) : -__builtin_amdgcn_sinf(rev); Dc[e] = f2bf(v * 0.0625f); }
        const float r128 = 0.08838834764831845f;
        for (int e = gt; e < 256 * 256; e += ngt) { const int r = e >> 8, cc = e & 255, ro = r >> 7, k1 = r & 127, ri = cc >> 7, n1 = cc & 127; const float rev = (float)((n1 * k1) & 127) * (1.0f / 128.0f);
            const float cs = __builtin_amdgcn_cosf(rev), sn = __builtin_amdgcn_sinf(rev);
            const float v = ro == 0 ? (ri == 0 ? cs : sn) : (ri == 0 ? -sn : cs); D1[e] = f2bf(v * r128);
            const float v2 = ro == 0 ? (ri == 0 ? cs : sn) : 0.f; D2[e] = f2bf(v2 * r128); }
        for (int e = gt; e < 128 * 128; e += ngt) { const int k1 = e >> 7, n2 = e & 127; const float rev = (float)(n2 * k1) * (1.0f / 16384.0f); TWp[e] = (f32x2){__builtin_amdgcn_cosf(rev), __builtin_amdgcn_sinf(rev)}; }
        for (int e = gt; e < 128 * 16; e += ngt) { const int k1 = e >> 4, n2 = e & 15; const float rev = (float)(n2 * k1) * (1.0f / 2048.0f); TWs[e] = (f32x2){__builtin_amdgcn_cosf(rev), __builtin_amdgcn_sinf(rev)}; }
        for (int e = gt; e < SP * 32; e += ngt) { const int pos = e >> 5, i = e & 31; double iv = 1.0; if (i & 1) iv *= 0.7498942093324559; if (i & 2) iv *= 0.5623413251903491; if (i & 4) iv *= 0.31622776601683794; if (i & 8) iv *= 0.1; if (i & 16) iv *= 0.01;
            double rv = (double)pos * iv * 0.15915494309189535; rv -= floor(rv); const float rev = (float)rv;
            RTw[e] = (f32x2){__builtin_amdgcn_cosf(rev), __builtin_amdgcn_sinf(rev)}; }
    }
    grid.sync(); OPQ();

    for (int layer = 0; layer < 4; ++layer) {
        const int kind = layer % 3, jm = layer / 3;
        const float* modl = mod + (size_t)layer * NSEQ * 6144;
        const float* xs0 = layer == 0 ? INP(0) : out; const float* xs1 = layer == 0 ? INP(1) : out + (size_t)TP * 1024;
        if (EN(1)) prep_phase(xs0, xs1, INP(6) + layer * 1024, modl, 0, 1, Hh, gw, ngw, lane);
        GSYNC();
        const char* wo_w; const float* wo_b = nullptr;
        if (kind == 0) {
            for (int part = 0; part < 2; ++part) { ProbF0 p{256, (const char*)(ws + WS_DC), (const char*)Hh, BIG, part, G, bx}; if (EN(2)) pg8::gemm_phase(lds3, p); }
            GSYNC();
            { ProbF1 p{256, (const char*)(ws + WS_D1), BIG, (const f32x2*)(ws + WS_TWP), (const f32x2*)(ws + WS_TWS), G, bx}; if (EN(3)) pg8::gemm_phase(lds3, p); }
            GSYNC();
            { ProbF2p p{256, (const char*)(ws + WS_D2), (const char*)BIG, Hh, G, bx}; if (EN(4)) pg8::gemm_phase(lds3, p); }
            if (EN(5)) {
                constexpr float C16[16] = {1.f, 0.9238795325112867f, 0.7071067811865476f, 0.3826834323650898f, 0.f, -0.3826834323650898f, -0.7071067811865476f, -0.9238795325112867f,
                                           -1.f, -0.9238795325112867f, -0.7071067811865476f, -0.3826834323650898f, 0.f, 0.3826834323650898f, 0.7071067811865476f, 0.9238795325112867f};
                int tid2 = tid; asm volatile("" : "+v"(tid2));
                const int gt = vcu * 512 + tid2, ngt = G * 512;
                for (int it = gt; it < 128 * 32 * 1024; it += ngt) {
                    const int cch = it & 1023, b = (it >> 10) & 31, k1 = it >> 15;
                    const bf16_t* src = BIG + (size_t)cch * (2 * T) + 65536 + (size_t)(b >> 4) * 65536 + (size_t)(k1 * 16 + (b & 15)) * 32;
                    float yr[16], yi[16];
#pragma unroll
                    for (int q = 0; q < 4; ++q) { const u32x4 w = *(const u32x4*)(src + 8 * q);
#pragma unroll
                        for (int e = 0; e < 4; ++e) { const float lo = __uint_as_float(w[e] << 16), hv = __uint_as_float(w[e] & 0xffff0000u);
                            if (q < 2) { yr[8 * q + 2 * e] = lo; yr[8 * q + 2 * e + 1] = hv; } else { yi[8 * (q - 2) + 2 * e] = lo; yi[8 * (q - 2) + 2 * e + 1] = hv; } } }
                    bf16_t* dst = Hh + (size_t)(TP + b * SS + k1) * 1024 + cch;
#pragma unroll
                    for (int k2 = 0; k2 < 16; ++k2) { float acc = 0.f;
#pragma unroll
                        for (int n2 = 0; n2 < 16; ++n2) { const int mm = (n2 * k2) & 15; acc += yr[n2] * C16[mm] + yi[n2] * C16[(mm + 12) & 15]; }
                        dst[(size_t)(128 * k2) * 1024] = f2bf(acc * 0.25f); }
                }
            }
            GSYNC();
            wo_w = (const char*)(ws + WS_FNET + (size_t)jm * 1024 * 1024 * 2); wo_b = INP(9) + jm * 1024;
        } else if (kind == 1) {
            { ProbQKV p{1024, (const char*)Hh, (const char*)(ws + WS_SWAQKV), 5, 1, BIG, 1280, VTB, G, bx}; if (EN(6)) pg8::gemm_phase(lds3, p); }
            GSYNC();
            if (EN(7)) qkpost_phase<3>(BIG, 1280, 16, 20, INP(11), INP(12), RT, gw, ngw, lane);
            GSYNC();
            {
                AttnArgs a; a.QK = BIG; a.ldq = 1280; a.VT = VTB; a.O = Hh; a.lam = 0.f; a.post = 0.f; a.subg = nullptr;
                float gqm = 0.f, gkm = 0.f, skm = 0.f;
                for (int i = 0; i < 64; ++i) { gqm = fmaxf(gqm, fabsf(INP(11)[i])); gkm = fmaxf(gkm, fabsf(INP(12)[i])); }
                for (int i = 0; i < 16; ++i) skm = fmaxf(skm, fabsf(INP(13)[i]));
                const bool fast = (8.0f * LOG2E * gqm * gkm < 40.0f) && (skm * LOG2E < 40.0f);
                auto run_units = [&](auto TRK_) { constexpr bool TRK = decltype(TRK_)::value;
                for (int ph = 0; ph < 2; ++ph) {
                    const int NU = ph == 0 ? 2048 : 4096, nqb = ph == 0 ? 128 : 16;
                    const int u0 = (int)((long)NU * vcu / G), u1 = (int)((long)NU * (vcu + 1) / G);
                    for (int u = u0; u < u1; ++u) {
                        const int gp = u & 1, n = (u >> 1) % nqb, bk = (u >> 1) / nqb, kvh = bk & 3, b = bk >> 2;
                        a.S = ph == 0 ? SP : SS; a.seq0 = ph == 0 ? b * SP : TP + b * SS; a.qpos0 = n * 128;
                        const int hd0 = kvh * 4 + gp * 2;
                        a.qcol0 = hd0 * 64; a.kcol = 1024 + kvh * 64; a.vrow0 = kvh * 64; a.ocol0 = hd0 * 64;
                        const int lo = a.qpos0 - 128 < 0 ? 0 : a.qpos0 - 128, hi_ = a.qpos0 + 256 > a.S ? a.S : a.qpos0 + 256;
                        a.kt_lo = lo >> 6; a.kt_hi = hi_ >> 6;
                        a.sink2a = INP(13)[hd0] * LOG2E; a.sink2b = INP(13)[hd0 + 1] * LOG2E;
                        if (EN(8)) attn_unit<0, TRK>(lds, a);
                    }
                }
                };
                if (fast) run_units(std::false_type{}); else run_units(std::true_type{});
            }
            GSYNC();
            wo_w = (const char*)(ws + WS_SWAWO);
        } else {
            { ProbQKV p{1024, (const char*)Hh, (const char*)(ws + WS_DIFFQKV), 8, 4, BIG, 2048, VTB, G, bx}; if (EN(6)) pg8::gemm_phase(lds3, p); }
            GSYNC();
            if (EN(7)) qkpost_phase<4>(BIG, 2048, 16, 32, INP(16), INP(17), RT, gw, ngw, lane);
            GSYNC();
            {
                float d1 = 0.f, d2 = 0.f;
                for (int i = 0; i < 64; ++i) { d1 += INP(18)[i] * INP(19)[i]; d2 += INP(20)[i] * INP(21)[i]; }
                const float lambda_init = 0.8f - 0.6f * 0.5488116360940264f;
                AttnArgs a; a.QK = BIG; a.ldq = 2048; a.VT = VTB; a.O = Hh; a.lam = __expf(d1) - __expf(d2) + lambda_init; a.post = 1.0f - lambda_init; a.subg = INP(22);
                a.sink2a = 0.f; a.sink2b = 0.f;
                float gqm = 0.f, gkm = 0.f;
                for (int i = 0; i < 64; ++i) { gqm = fmaxf(gqm, fabsf(INP(16)[i])); gkm = fmaxf(gkm, fabsf(INP(17)[i])); }
                const bool fast = (8.0f * LOG2E * gqm * gkm < 40.0f);
                auto run_units = [&](auto TRK_) { constexpr bool TRK = decltype(TRK_)::value;
                for (int ph = 0; ph < 2; ++ph) {
                    const int NU = ph == 0 ? 2048 : 4096, nqb = ph == 0 ? 128 : 16;
                    const int u0 = (int)((long)NU * vcu / G), u1 = (int)((long)NU * (vcu + 1) / G);
                    for (int u = u0; u < u1; ++u) {
                        const int qb = u % nqb, pr = u / nqb, h = pr & 7, b = pr >> 3;
                        a.S = ph == 0 ? SP : SS; a.seq0 = ph == 0 ? b * SP : TP + b * SS; a.qpos0 = qb * 128;
                        a.qcol0 = h * 128; a.kcol = 1024 + h * 128; a.vrow0 = h * 128; a.ocol0 = h * 128;
                        a.kt_lo = 0; a.kt_hi = a.S >> 6;
                        if (EN(9)) attn_unit<1, TRK>(lds, a);
                    }
                }
                };
                if (fast) run_units(std::false_type{}); else run_units(std::true_type{});
            }
            GSYNC();
            wo_w = (const char*)(ws + WS_DIFFWO);
        }
        { ProbResid p{1024, (const char*)Hh, 2048u, wo_w, xs0, xs1, out, modl + 2 * 1024, wo_b, G, bx}; if (EN(10)) pg8::gemm_phase(lds3, p); }
        GSYNC();
        if (EN(1)) prep_phase(out, out + (size_t)TP * 1024, INP(7) + layer * 1024, modl, 3, 4, Hh, gw, ngw, lane);
        GSYNC();
        const char* gu = (const char*)(ws + WS_GU + layer * GU_STRIDE);
        { ProbHalo p{1024, (const char*)Hh, gu, Gh, G, bx}; if (EN(11)) pg8::gemm_phase(lds3, p); }
        GSYNC();
        { ProbGateUp p{1024, (const char*)Hh, gu, Gh, INP(26) + (size_t)layer * 3 * FF, INP(27) + (size_t)layer * FF, BIG, G, bx}; if (EN(12)) pg8::gemm_phase(lds3, p); }
        GSYNC();
        { ProbResid p{FF, (const char*)BIG, (unsigned)(FF * 2), (const char*)(ws + WS_DOWN + layer * DOWN_STRIDE), out, out + (size_t)TP * 1024, out, modl + 5 * 1024, nullptr, G, bx}; if (EN(13)) pg8::gemm_phase(lds3, p); }
        if (layer < 3) GSYNC();
    }
}

#undef ws
#undef out
#undef INP
#undef OPQ
#undef GSYNC
#undef mod
#undef Hh
#undef BIG
#undef VTB
#undef Gh
#undef RT
extern "C" void kernel_launch(void* const* d_in, const int* in_sizes, int n_in, void* d_out, int out_size, void* d_ws, size_t ws_size, hipStream_t stream) {
    static int grid = 0;
    if (grid == 0) {
        if (n_in != 29 || ws_size < WS_END) { fprintf(stderr, "kernel_launch: unexpected problem (n_in %d, ws %zu)\n", n_in, ws_size); grid = -1; return; }
        int dev = 0, cus = 0, per_cu = 0;
        hipGetDevice(&dev); hipDeviceGetAttribute(&cus, hipDeviceAttributeMultiprocessorCount, dev);
        hipFuncSetAttribute((const void*)fwd_kernel, hipFuncAttributeMaxDynamicSharedMemorySize, LDS_BYTES);
        if (hipOccupancyMaxActiveBlocksPerMultiprocessor(&per_cu, (const void*)fwd_kernel, 512, LDS_BYTES) != hipSuccess || per_cu < 1) per_cu = 1;
        (void)hipGetLastError();
        grid = cus * 1;
    }
    if (grid < 0) return;
    (void)hipMemsetAsync(d_ws, 0, 16384, stream);
    Args a{};
    for (int i = 0; i < 29; ++i) a.in[i] = (const float*)d_in[i];
    a.out = (float*)d_out; a.ws = (unsigned char*)d_ws;
    void* kargs[] = {&a};
    hipError_t e = hipLaunchCooperativeKernel((const void*)fwd_kernel, dim3(grid), dim3(512), kargs, LDS_BYTES, stream);
    if (e != hipSuccess) fprintf(stderr, "cooperative launch failed: %s (grid %d)\n", hipGetErrorString(e), grid);
}
```

```cpp
#include <hip/hip_runtime.h>
#include <hip/hip_cooperative_groups.h>
#include <cstdio>
#include <cstdint>
#include <cmath>
#include <type_traits>
namespace cg = cooperative_groups;

#define LAS __attribute__((address_space(3)))
#define GAS __attribute__((address_space(1)))
typedef unsigned short bf16_t;
typedef short bf16x8 __attribute__((ext_vector_type(8)));
typedef short s16x4 __attribute__((ext_vector_type(4)));
typedef float f32x4 __attribute__((ext_vector_type(4)));
typedef float f32x2 __attribute__((ext_vector_type(2)));
typedef float f32x16 __attribute__((ext_vector_type(16)));
typedef unsigned u32x4 __attribute__((ext_vector_type(4)));
typedef unsigned u32x2 __attribute__((ext_vector_type(2)));

constexpr int T = 98304, TP = 32768, SP = 16384, SS = 2048, DM = 1024, FF = 2816, NSEQ = 34;
constexpr float EPS = 1e-6f;
constexpr float LOG2E = 1.4426950408889634f;
constexpr size_t MiB = 1u << 20;
constexpr size_t WS_DC = 1 * MiB, WS_D1 = WS_DC + 262144, WS_D2 = WS_D1 + 131072, WS_TWP = WS_D2 + 131072, WS_TWS = WS_TWP + 131072;
constexpr size_t WS_ROPE = 2 * MiB, WS_MOD = 6 * MiB;
constexpr size_t WS_FNET = 10 * MiB, WS_SWAQKV = 14 * MiB, WS_SWAWO = 17 * MiB, WS_DIFFQKV = 19 * MiB, WS_DIFFWO = 25 * MiB;
constexpr size_t WS_GU = 27 * MiB, GU_STRIDE = (size_t)5632 * 1024 * 2, WS_DOWN = 71 * MiB, DOWN_STRIDE = (size_t)1024 * 2816 * 2;
constexpr size_t WS_HALO = 96 * MiB, WS_H = 130 * MiB, WS_BIG = 322 * MiB, WS_VT = 706 * MiB, WS_END = 898 * MiB;
static_assert(WS_GU + 4 * GU_STRIDE <= WS_DOWN && WS_DOWN + 4 * DOWN_STRIDE <= WS_HALO, "ws map");
static_assert(WS_HALO + (size_t)3072 * 2816 * 4 <= WS_H && WS_H + (size_t)T * 1024 * 2 <= WS_BIG && WS_BIG + (size_t)T * 2048 * 2 <= WS_VT, "ws map");
static_assert(WS_BIG + (size_t)T * FF * 2 <= WS_END && WS_VT + (size_t)T * 1024 * 2 <= WS_END, "ws map");
constexpr int LDS_BYTES = 163840;

__device__ __forceinline__ unsigned cvt_pk_bf16(float lo, float hi) { unsigned r; asm volatile("v_cvt_pk_bf16_f32 %0, %1, %2" : "=v"(r) : "v"(lo), "v"(hi)); return r; }
__device__ __forceinline__ float bf2f(unsigned short b) { return __uint_as_float(((unsigned)b) << 16); }
__device__ __forceinline__ unsigned short f2bf(float f) { return (unsigned short)(cvt_pk_bf16(f, 0.f) & 0xffffu); }
__device__ __forceinline__ int seq_of(int row) { return row < TP ? (row >> 14) : 2 + ((row - TP) >> 11); }
__device__ __forceinline__ int pos_of(int row) { return row < TP ? (row & (SP - 1)) : ((row - TP) & (SS - 1)); }
template <int M> __device__ __forceinline__ float swz_xor(float v) { return __builtin_bit_cast(float, __builtin_amdgcn_ds_swizzle(__builtin_bit_cast(int, v), (M << 10) | 0x1f)); }
__device__ __forceinline__ float xor32_sum(float v) { auto rr = __builtin_amdgcn_permlane32_swap(__float_as_uint(v), __float_as_uint(v), false, false); return __uint_as_float(rr[0]) + __uint_as_float(rr[1]); }
__device__ __forceinline__ float xor32_max(float v) { auto rr = __builtin_amdgcn_permlane32_swap(__float_as_uint(v), __float_as_uint(v), false, false); return fmaxf(__uint_as_float(rr[0]), __uint_as_float(rr[1])); }
__device__ __forceinline__ float xor32_partner(float v, bool low_half) { auto rr = __builtin_amdgcn_permlane32_swap(__float_as_uint(v), __float_as_uint(v), false, false); return low_half ? __uint_as_float(rr[1]) : __uint_as_float(rr[0]); }
__device__ __forceinline__ float wave_sum(float v) {
    v += swz_xor<1>(v); v += swz_xor<2>(v); v += swz_xor<4>(v); v += swz_xor<8>(v); v += swz_xor<16>(v);
    return xor32_sum(v);
}

namespace pg8 {
constexpr int BM = 256, BK = 64, HALF = 128, HTB = HALF * BK * 2, STAGE_BYTES = 8 * HTB;
__host__ __device__ __forceinline__ int lds_byte(int r, int c) { const int st = (r >> 4) * 2 + (c >> 5), rr = r & 15, cc = c & 31, ob = rr * 64 + cc * 2; return st * 1024 + (ob ^ (((ob >> 9) & 1) << 5)); }
__host__ __device__ __forceinline__ void stage_rc(int b, int& R, int& C) { const int st = b / 1024, sb = b % 1024, swz = sb ^ (((sb >> 9) & 1) << 5); R = (st >> 1) * 16 + swz / 64; C = (st & 1) * 32 + (swz % 64) / 2; }
__host__ __device__ __forceinline__ int perm32(int rho) { const int n = rho >> 4, i = rho & 15; return 8 * (i >> 2) + 4 * n + (i & 3); }
struct Unit { int pm, pn, z; };
__device__ __forceinline__ void tile_of(int L, int nM, int nN, int& pm, int& pn) {
    const int nwg = nM * nN; int wgid = L;
    { const int q = nwg / 8, r = nwg % 8, xcd = wgid % 8, off = wgid / 8; wgid = (xcd < r ? xcd * (q + 1) : r * (q + 1) + (xcd - r) * q) + off; }
    const int nig = 8 * nN, gid = wgid / nig, fm = gid * 8, gsz = (nM - fm) < 8 ? (nM - fm) : 8;
    pm = fm + ((wgid % nig) % gsz); pn = (wgid % nig) / gsz;
}
template <class P>
__device__ __forceinline__ void gemm_phase(LAS unsigned char* lds, const P& p) {
    int tid = threadIdx.x; asm volatile("" : "+v"(tid));
    const int wid = __builtin_amdgcn_readfirstlane(tid >> 6), lane = tid & 63, wr = wid >> 2, wc = wid & 3, fr = lane & 15, fq = lane >> 4;
    const int K = p.K, nt = K / BK;
    unsigned voffA[2], voffB[2];
#pragma unroll
    for (int i = 0; i < 2; ++i) { int R, C; stage_rc(tid * 16 + i * 8192, R, C); const int Rb = (R & ~31) + perm32(R & 31);
        voffA[i] = p.a_rowoff(R) + (unsigned)C * 2u; voffB[i] = p.b_rowoff(Rb) + (unsigned)C * 2u; }
    const size_t kstep = (size_t)(BK * 2);
    const size_t hstepA = p.a_hstep(), hstepB = p.b_hstep();
    const unsigned ldsw = (unsigned)wid * 1024u;
    const int aoff = lds_byte(wr * 64 + fr, fq * 8), boff = lds_byte(wc * 32 + fr, fq * 8);
#define PG8_SA(b, h) (((b) * 2 + (h)) * HTB)
#define PG8_SB(b, h) ((4 + (b) * 2 + (h)) * HTB)
#define PG8_STAGE(bufoff, gbase, voff) do { _Pragma("unroll") for (int _i = 0; _i < 2; ++_i) \
        __builtin_amdgcn_global_load_lds((const unsigned*)((const char*)(gbase) + (voff)[_i]), (LAS unsigned*)(lds + (bufoff) + ldsw + _i * 8192), 16, 0, 0); } while (0)
#define PG8_LDA(dst, b, h) do { _Pragma("unroll") for (int m = 0; m < 4; ++m) _Pragma("unroll") for (int k = 0; k < 2; ++k) dst[m][k] = *(const LAS bf16x8*)(lds + PG8_SA(b, h) + aoff + m * 2048 + k * 1024); } while (0)
#define PG8_LDB(dst, b, h) do { _Pragma("unroll") for (int n = 0; n < 2; ++n) _Pragma("unroll") for (int k = 0; k < 2; ++k) dst[n][k] = *(const LAS bf16x8*)(lds + PG8_SB(b, h) + boff + n * 2048 + k * 1024); } while (0)
#define PG8_MMA(ai, bj, At, Bt) do { __builtin_amdgcn_s_setprio(1); _Pragma("unroll") for (int m = 0; m < 4; ++m) _Pragma("unroll") for (int n = 0; n < 2; ++n) _Pragma("unroll") for (int k = 0; k < 2; ++k) \
        acc[ai][bj][m][n] = __builtin_amdgcn_mfma_f32_16x16x32_bf16(Bt[n][k], At[m][k], acc[ai][bj][m][n], 0, 0, 0); __builtin_amdgcn_s_setprio(0); } while (0)
#define PG8_WAIT_V(n) asm volatile("s_waitcnt vmcnt(" #n ")" ::: "memory")
#define PG8_WAIT_L(n) asm volatile("s_waitcnt lgkmcnt(" #n ")" ::: "memory")
#define PG8_BAR __builtin_amdgcn_s_barrier()
#define PG8_SCHED __builtin_amdgcn_sched_barrier(0)
    Unit cur, nxt; int ui = 0;
    if (!p.next(0, cur)) return;
    f32x4 acc[2][2][4][2];
#pragma unroll
    for (int a = 0; a < 2; ++a)
#pragma unroll
        for (int b = 0; b < 2; ++b)
#pragma unroll
            for (int m = 0; m < 4; ++m)
#pragma unroll
                for (int n = 0; n < 2; ++n) acc[a][b][m][n] = (f32x4){0.f, 0.f, 0.f, 0.f};
    bf16x8 At[4][2], B0[2][2], B1[2][2];
    const char* cA = p.a_base(cur); const char* cB = p.b_base(cur);
    PG8_STAGE(PG8_SB(0, 0), cB, voffB); PG8_STAGE(PG8_SB(0, 1), cB + hstepB, voffB); PG8_STAGE(PG8_SA(0, 0), cA, voffA); PG8_STAGE(PG8_SA(0, 1), cA + hstepA, voffA);
    if (wr == 1) PG8_BAR;
    PG8_WAIT_V(2); PG8_BAR;
    PG8_STAGE(PG8_SB(1, 0), cB + kstep, voffB); PG8_STAGE(PG8_SA(1, 0), cA + kstep, voffA); PG8_STAGE(PG8_SB(1, 1), cB + hstepB + kstep, voffB);
    PG8_WAIT_V(6); PG8_BAR;
    for (;;) {
        const bool has_next = p.next(ui + 1, nxt);
        const char* nA = has_next ? p.a_base(nxt) : cA; const char* nB = has_next ? p.b_base(nxt) : cB;
        for (int t = 0; t < nt; t += 2) {
            const bool last = (t == nt - 2);
            const char* a1 = cA + (size_t)(t + 1) * kstep;
            const char* a2 = last ? nA : cA + (size_t)(t + 2) * kstep; const char* b2 = last ? nB : cB + (size_t)(t + 2) * kstep;
            const char* a3 = a2 + kstep; const char* b3 = b2 + kstep;
            PG8_LDB(B0, 0, 0); PG8_LDB(B1, 0, 1); PG8_SCHED; PG8_LDA(At, 0, 0); PG8_STAGE(PG8_SA(1, 1), a1 + hstepA, voffA);
            PG8_WAIT_V(8); PG8_WAIT_L(0); PG8_BAR; PG8_MMA(0, 0, At, B0); PG8_MMA(0, 1, At, B1); PG8_BAR; PG8_SCHED;
            PG8_LDA(At, 0, 1); PG8_STAGE(PG8_SB(0, 0), b2, voffB); PG8_STAGE(PG8_SB(0, 1), b2 + hstepB, voffB); PG8_STAGE(PG8_SA(0, 0), a2, voffA);
            PG8_WAIT_V(8); PG8_WAIT_L(0); PG8_BAR; PG8_MMA(1, 0, At, B0); PG8_MMA(1, 1, At, B1); PG8_BAR; PG8_SCHED;
            PG8_LDB(B0, 1, 0); PG8_LDB(B1, 1, 1); PG8_SCHED; PG8_LDA(At, 1, 0); PG8_STAGE(PG8_SA(0, 1), a2 + hstepA, voffA);
            PG8_WAIT_V(8); PG8_WAIT_L(0); PG8_BAR; PG8_MMA(0, 0, At, B0); PG8_MMA(0, 1, At, B1); PG8_BAR; PG8_SCHED;
            PG8_LDA(At, 1, 1); PG8_STAGE(PG8_SB(1, 0), b3, voffB); PG8_STAGE(PG8_SB(1, 1), b3 + hstepB, voffB); PG8_STAGE(PG8_SA(1, 0), a3, voffA);
            PG8_WAIT_V(8); PG8_WAIT_L(0); PG8_BAR; PG8_MMA(1, 0, At, B0); PG8_MMA(1, 1, At, B1); PG8_BAR; PG8_SCHED;
        }
        if (wr == 0) PG8_BAR;
        { int fr_ = fr, fq_ = fq; asm volatile("" : "+v"(fr_), "+v"(fq_)); p.epi(acc, cur, wr, wc, fr_, fq_); }
        if (!has_next) break;
#pragma unroll
        for (int a = 0; a < 2; ++a)
#pragma unroll
            for (int b = 0; b < 2; ++b)
#pragma unroll
                for (int m = 0; m < 4; ++m)
#pragma unroll
                    for (int n = 0; n < 2; ++n) acc[a][b][m][n] = (f32x4){0.f, 0.f, 0.f, 0.f};
        cur = nxt; cA = nA; cB = nB; ++ui;
        if (wr == 1) PG8_BAR;
    }
    PG8_WAIT_V(0);
    PG8_BAR;
#undef PG8_SA
#undef PG8_SB
#undef PG8_STAGE
#undef PG8_LDA
#undef PG8_LDB
#undef PG8_MMA
#undef PG8_WAIT_V
#undef PG8_WAIT_L
#undef PG8_BAR
#undef PG8_SCHED
}
typedef f32x4 Acc[2][2][4][2];
__device__ __forceinline__ void store_tile_bf16(Acc& acc, bf16_t* base, size_t ldc, int wr, int wc, int fr, int fq) {
#pragma unroll
    for (int ai = 0; ai < 2; ++ai)
#pragma unroll
        for (int m = 0; m < 4; ++m) { bf16_t* rowp = base + (size_t)(ai * HALF + wr * 64 + m * 16 + fr) * ldc + wc * 32 + 8 * fq;
#pragma unroll
            for (int bj = 0; bj < 2; ++bj) { const f32x4 v0 = acc[ai][bj][m][0], v1 = acc[ai][bj][m][1]; u32x4 w;
                w.x = cvt_pk_bf16(v0[0], v0[1]); w.y = cvt_pk_bf16(v0[2], v0[3]); w.z = cvt_pk_bf16(v1[0], v1[1]); w.w = cvt_pk_bf16(v1[2], v1[3]);
                *(u32x4*)(rowp + bj * HALF) = w; } }
}
}
using pg8::Unit; using pg8::Acc; using pg8::tile_of;

struct ProbQKV {
    int K; const char* H; const char* W; int nqk, nv; bf16_t* QKout; int ldq; bf16_t* VTout; int G, c;
    __device__ __forceinline__ unsigned a_rowoff(int R) const { return (unsigned)R * 2048u; }
    __device__ __forceinline__ unsigned b_rowoff(int R) const { return (unsigned)R * 2048u; }
    __device__ __forceinline__ size_t a_hstep() const { return (size_t)128 * 2048; }
    __device__ __forceinline__ size_t b_hstep() const { return (size_t)128 * 2048; }
    __device__ __forceinline__ bool next(int i, Unit& u) const { long L = (long)i * G + c; const int n0 = 384 * nqk, n1 = 384 * nv;
        if (L < n0) { u.z = 0; tile_of((int)L, 384, nqk, u.pm, u.pn); return true; } L -= n0;
        if (L < n1) { u.z = 1; tile_of((int)L, nv, 384, u.pm, u.pn); return true; } return false; }
    __device__ __forceinline__ const char* a_base(const Unit& u) const { return u.z == 0 ? H + (size_t)u.pm * 256 * 2048 : W + (size_t)(nqk * 256 + u.pm * 256) * 2048; }
    __device__ __forceinline__ const char* b_base(const Unit& u) const { return u.z == 0 ? W + (size_t)u.pn * 256 * 2048 : H + (size_t)u.pn * 256 * 2048; }
    __device__ __forceinline__ void epi(Acc& acc, const Unit& u, int wr, int wc, int fr, int fq) const {
        bf16_t* base; size_t ldc;
        if (u.z == 0) { ldc = (size_t)ldq; base = QKout + (size_t)u.pm * 256 * ldc + u.pn * 256; } else { ldc = (size_t)T; base = VTout + (size_t)u.pm * 256 * ldc + u.pn * 256; }
        pg8::store_tile_bf16(acc, base, ldc, wr, wc, fr, fq);
    }
};
struct ProbResid {
    int K; const char* A; unsigned a_pitch; const char* W; const float* xin0; const float* xin1; float* out; const float* gate; const float* bias; int G, c;
    __device__ __forceinline__ unsigned a_rowoff(int R) const { return (unsigned)R * a_pitch; }
    __device__ __forceinline__ unsigned b_rowoff(int R) const { return (unsigned)R * (unsigned)(K * 2); }
    __device__ __forceinline__ size_t a_hstep() const { return (size_t)128 * a_pitch; }
    __device__ __forceinline__ size_t b_hstep() const { return (size_t)128 * K * 2; }
    __device__ __forceinline__ bool next(int i, Unit& u) const { const long L = (long)i * G + c; if (L >= 1536) return false; u.z = 0; tile_of((int)L, 384, 4, u.pm, u.pn); return true; }
    __device__ __forceinline__ const char* a_base(const Unit& u) const { return A + (size_t)u.pm * 256 * a_pitch; }
    __device__ __forceinline__ const char* b_base(const Unit& u) const { return W + (size_t)u.pn * 256 * K * 2; }
    __device__ __forceinline__ void epi(Acc& acc, const Unit& u, int wr, int wc, int fr, int fq) const {
        const int row0 = u.pm * 256; const float* gp = gate + (size_t)seq_of(row0) * 6144;
#pragma unroll
        for (int bj = 0; bj < 2; ++bj) { const int col = u.pn * 256 + bj * 128 + wc * 32 + 8 * fq;
            const f32x4 g0 = *(const f32x4*)(gp + col), g1 = *(const f32x4*)(gp + col + 4);
            f32x4 b0 = (f32x4){0.f, 0.f, 0.f, 0.f}, b1 = b0; if (bias) { b0 = *(const f32x4*)(bias + col); b1 = *(const f32x4*)(bias + col + 4); }
#pragma unroll
            for (int ai = 0; ai < 2; ++ai)
#pragma unroll
                for (int m = 0; m < 4; ++m) { const int row = row0 + ai * 128 + wr * 64 + m * 16 + fr;
                    const float* xs = (row < TP ? xin0 + (size_t)row * 1024 : xin1 + (size_t)(row - TP) * 1024) + col;
                    const f32x4 x0 = *(const f32x4*)xs, x1 = *(const f32x4*)(xs + 4);
                    float* op = out + (size_t)row * 1024 + col;
                    *(f32x4*)op = x0 + g0 * (acc[ai][bj][m][0] + b0); *(f32x4*)(op + 4) = x1 + g1 * (acc[ai][bj][m][1] + b1); } }
    }
};
struct ProbHalo {
    int K; const char* H; const char* W; float* Gh; int G, c;
    __device__ __forceinline__ unsigned a_rowoff(int R) const { return (unsigned)(64 * (R >> 1) + 63 * (R & 1)) * 2048u; }
    __device__ __forceinline__ unsigned b_rowoff(int R) const { return (unsigned)R * 2048u; }
    __device__ __forceinline__ size_t a_hstep() const { return (size_t)4096 * 2048; }
    __device__ __forceinline__ size_t b_hstep() const { return (size_t)256 * 2048; }
    __device__ __forceinline__ bool next(int i, Unit& u) const { const long L = (long)i * G + c; if (L >= 132) return false; u.z = 0; u.pm = (int)(L % 12); u.pn = (int)(L / 12); return true; }
    __device__ __forceinline__ const char* a_base(const Unit& u) const { return H + (size_t)u.pm * 8192 * 2048; }
    __device__ __forceinline__ const char* b_base(const Unit& u) const { return W + (size_t)u.pn * 512 * 2048; }
    __device__ __forceinline__ void epi(Acc& acc, const Unit& u, int wr, int wc, int fr, int fq) const {
#pragma unroll
        for (int ai = 0; ai < 2; ++ai)
#pragma unroll
            for (int m = 0; m < 4; ++m) { float* rp = Gh + (size_t)(u.pm * 256 + ai * 128 + wr * 64 + m * 16 + fr) * FF + u.pn * 256 + wc * 32 + 8 * fq;
#pragma unroll
                for (int bj = 0; bj < 2; ++bj) { *(f32x4*)(rp + bj * 128) = acc[ai][bj][m][0]; *(f32x4*)(rp + bj * 128 + 4) = acc[ai][bj][m][1]; } }
    }
};
struct ProbGateUp {
    int K; const char* H; const char* W; const float* Gh; const float* cw; const float* cb; bf16_t* act; int G, c;
    __device__ __forceinline__ unsigned a_rowoff(int R) const { return (unsigned)R * 2048u; }
    __device__ __forceinline__ unsigned b_rowoff(int R) const { return (unsigned)R * 2048u; }
    __device__ __forceinline__ size_t a_hstep() const { return (size_t)128 * 2048; }
    __device__ __forceinline__ size_t b_hstep() const { return (size_t)128 * 2048; }
    __device__ __forceinline__ bool next(int i, Unit& u) const { const long L = (long)i * G + c; if (L >= 384 * 22) return false; u.z = 0; tile_of((int)L, 384, 22, u.pm, u.pn); return true; }
    __device__ __forceinline__ const char* a_base(const Unit& u) const { return H + (size_t)u.pm * 256 * 2048; }
    __device__ __forceinline__ const char* b_base(const Unit& u) const { return W + (size_t)u.pn * 256 * 2048; }
    __device__ __forceinline__ void epi(Acc& acc, const Unit& u, int wr, int wc, int fr, int fq) const {
        const int lane = threadIdx.x & 63;
        const int colb = u.pn * 128 + wc * 32 + 8 * fq;
        float w0[8], w1[8], w2[8], bb[8];
#pragma unroll
        for (int q = 0; q < 2; ++q) { const f32x4 a = *(const f32x4*)(cw + colb + 4 * q), b = *(const f32x4*)(cw + FF + colb + 4 * q), cc = *(const f32x4*)(cw + 2 * FF + colb + 4 * q), d = *(const f32x4*)(cb + colb + 4 * q);
#pragma unroll
            for (int j = 0; j < 4; ++j) { w0[4 * q + j] = a[j]; w1[4 * q + j] = b[j]; w2[4 * q + j] = cc[j]; bb[4 * q + j] = d[j]; } }
        const int src_up = (fr == 0) ? lane + 15 : lane - 1, src_dn = (fr == 15) ? lane - 15 : lane + 1;
#pragma unroll
        for (int ai = 0; ai < 2; ++ai) {
            const int blk = u.pm * 4 + ai * 2 + wr;
            const bool first = blk < 512 ? ((blk & 255) == 0) : (((blk - 512) & 31) == 0);
            const bool lastb = blk < 512 ? ((blk & 255) == 255) : (((blk - 512) & 31) == 31);
            float hp[8], hn[8];
#pragma unroll
            for (int q = 0; q < 2; ++q) { f32x4 a = (f32x4){0.f, 0.f, 0.f, 0.f}, b = a;
                if (!first) a = *(const f32x4*)(Gh + (size_t)(2 * (blk - 1) + 1) * FF + colb + 4 * q);
                if (!lastb) b = *(const f32x4*)(Gh + (size_t)(2 * (blk + 1)) * FF + colb + 4 * q);
#pragma unroll
                for (int j = 0; j < 4; ++j) { hp[4 * q + j] = a[j]; hn[4 * q + j] = b[j]; } }
#pragma unroll
            for (int n = 0; n < 2; ++n)
#pragma unroll
                for (int j = 0; j < 4; ++j) { const int cidx = 4 * n + j; float rup[4], rdn[4];
#pragma unroll
                    for (int m = 0; m < 4; ++m) { const float gv = acc[ai][0][m][n][j]; const int gi = __builtin_bit_cast(int, gv);
                        rup[m] = __builtin_bit_cast(float, __builtin_amdgcn_update_dpp(gi, gi, 0x121, 0xf, 0xf, false)); rdn[m] = __builtin_bit_cast(float, __builtin_amdgcn_update_dpp(gi, gi, 0x12f, 0xf, 0xf, false)); }
#pragma unroll
                    for (int m = 0; m < 4; ++m) {
                        const float prev = (fr == 0) ? (m == 0 ? hp[cidx] : rup[m == 0 ? 0 : m - 1]) : rup[m];
                        const float nextv = (fr == 15) ? (m == 3 ? hn[cidx] : rdn[m == 3 ? 3 : m + 1]) : rdn[m];
                        const float cv = w0[cidx] * prev + w1[cidx] * acc[ai][0][m][n][j] + w2[cidx] * nextv + bb[cidx];
                        const float sg = __builtin_amdgcn_rcpf(1.0f + __expf(-cv));
                        acc[ai][0][m][n][j] = cv * sg * acc[ai][1][m][n][j]; } }
#pragma unroll
            for (int m = 0; m < 4; ++m) { const int row = u.pm * 256 + ai * 128 + wr * 64 + m * 16 + fr; const f32x4 v0 = acc[ai][0][m][0], v1 = acc[ai][0][m][1]; u32x4 w;
                w.x = cvt_pk_bf16(v0[0], v0[1]); w.y = cvt_pk_bf16(v0[2], v0[3]); w.z = cvt_pk_bf16(v1[0], v1[1]); w.w = cvt_pk_bf16(v1[2], v1[3]);
                *(u32x4*)(act + (size_t)row * FF + colb) = w; }
        }
    }
};
struct ProbF0 {
    int K; const char* Dc; const char* H; bf16_t* ZT; int part; int G, c;
    __device__ __forceinline__ unsigned a_rowoff(int R) const { return (unsigned)R * 512u; }
    __device__ __forceinline__ unsigned b_rowoff(int R) const { return (unsigned)R * (part == 0 ? 128u * 2048u : 16u * 2048u); }
    __device__ __forceinline__ size_t a_hstep() const { return (size_t)128 * 512; }
    __device__ __forceinline__ size_t b_hstep() const { return (size_t)2048; }
    __device__ __forceinline__ bool next(int i, Unit& u) const { const long L = (long)i * G + c; const int nct = part == 0 ? 128 : 256; if (L >= 8 * nct) return false;
        u.pn = (int)(L / 8); u.pm = (int)(L & 1); u.z = (int)((L >> 1) & 3); return true; }
    __device__ __forceinline__ const char* a_base(const Unit& u) const { return Dc + (size_t)u.pm * 256 * 512; }
    __device__ __forceinline__ const char* b_base(const Unit& u) const {
        const int ct = u.pn; const int tok = part == 0 ? (ct >> 6) * SP + 2 * (ct & 63) : TP + (ct >> 3) * SS + 2 * (ct & 7);
        return H + (size_t)tok * 2048 + u.z * 512; }
    __device__ __forceinline__ void epi(Acc& acc, const Unit& u, int wr, int wc, int fr, int fq) const {
        const int jb0 = (part == 0 ? 0 : 256) + 2 * u.pn;
#pragma unroll
        for (int ai = 0; ai < 2; ++ai)
#pragma unroll
            for (int m = 0; m < 4; ++m) { const int kc = ai * 128 + wr * 64 + m * 16 + fr; bf16_t* rp = ZT + (size_t)(u.z * 256 + kc) * (2 * T) + u.pm * 128 + wc * 32 + 8 * fq;
#pragma unroll
                for (int bj = 0; bj < 2; ++bj) { const f32x4 v0 = acc[ai][bj][m][0], v1 = acc[ai][bj][m][1]; u32x4 w;
                    w.x = cvt_pk_bf16(v0[0], v0[1]); w.y = cvt_pk_bf16(v0[2], v0[3]); w.z = cvt_pk_bf16(v1[0], v1[1]); w.w = cvt_pk_bf16(v1[2], v1[3]);
                    *(u32x4*)(rp + (size_t)(jb0 + bj) * 256) = w; } }
    }
};
struct ProbF1 {
    int K; const char* D1; bf16_t* ZT; const f32x2* TWp; const f32x2* TWs; int G, c;
    __device__ __forceinline__ unsigned a_rowoff(int R) const { return (unsigned)R * 512u; }
    __device__ __forceinline__ unsigned b_rowoff(int R) const { return (unsigned)R * 512u; }
    __device__ __forceinline__ size_t a_hstep() const { return (size_t)128 * 512; }
    __device__ __forceinline__ size_t b_hstep() const { return (size_t)128 * 512; }
    __device__ __forceinline__ bool next(int i, Unit& u) const { const long L = (long)i * G + c; if (L >= 3072) return false; u.pm = 0; u.pn = (int)(L / 3); u.z = (int)(L % 3); return true; }
    __device__ __forceinline__ const char* a_base(const Unit&) const { return D1; }
    __device__ __forceinline__ const char* b_base(const Unit& u) const { return (const char*)ZT + ((size_t)u.pn * (2 * T) + (size_t)u.z * 65536) * 2; }
    __device__ __forceinline__ void epi(Acc& acc, const Unit& u, int wr, int wc, int fr, int fq) const {
        bf16_t* reg = ZT + (size_t)u.pn * (2 * T) + (size_t)u.z * 65536;
#pragma unroll
        for (int m = 0; m < 4; ++m) { const int k1 = wr * 64 + m * 16 + fr;
#pragma unroll
            for (int bj = 0; bj < 2; ++bj) {
                int n2b; size_t off; const f32x2* tw;
                if (u.z == 0) { n2b = wc * 32 + 8 * fq; tw = TWp + k1 * 128 + n2b; off = (size_t)((k1 * 2 + bj) * 2) * 128 + n2b; }
                else { n2b = 8 * (fq & 1); const int blo = 8 * bj + 2 * wc + (fq >> 1); tw = TWs + k1 * 16 + n2b; off = (size_t)((k1 * 16 + blo) * 2) * 16 + n2b; }
                const int ro_stride = (u.z == 0) ? 128 : 16;
                float re[8], im[8];
#pragma unroll
                for (int n = 0; n < 2; ++n)
#pragma unroll
                    for (int j = 0; j < 4; ++j) { const f32x2 t = tw[4 * n + j]; const float a = acc[0][bj][m][n][j], b = acc[1][bj][m][n][j];
                        re[4 * n + j] = a * t.x + b * t.y; im[4 * n + j] = b * t.x - a * t.y; }
                u32x4 wre, wim;
                wre.x = cvt_pk_bf16(re[0], re[1]); wre.y = cvt_pk_bf16(re[2], re[3]); wre.z = cvt_pk_bf16(re[4], re[5]); wre.w = cvt_pk_bf16(re[6], re[7]);
                wim.x = cvt_pk_bf16(im[0], im[1]); wim.y = cvt_pk_bf16(im[2], im[3]); wim.z = cvt_pk_bf16(im[4], im[5]); wim.w = cvt_pk_bf16(im[6], im[7]);
                *(u32x4*)(reg + off) = wre; *(u32x4*)(reg + off + ro_stride) = wim; asm volatile("" ::: "memory"); } }
    }
};
struct ProbF2p {
    int K; const char* D2; const char* ZT; bf16_t* F; int G, c;
    __device__ __forceinline__ unsigned a_rowoff(int R) const { return (unsigned)R * 512u; }
    __device__ __forceinline__ unsigned b_rowoff(int R) const { return (unsigned)R * (unsigned)(2 * T * 2); }
    __device__ __forceinline__ size_t a_hstep() const { return (size_t)128 * 512; }
    __device__ __forceinline__ size_t b_hstep() const { return (size_t)128 * (2 * T * 2); }
    __device__ __forceinline__ bool next(int i, Unit& u) const { const long L = (long)i * G + c; if (L >= 1024) return false; u.pm = 0; u.pn = (int)(L >> 2); u.z = (int)(L & 3); return true; }
    __device__ __forceinline__ const char* a_base(const Unit&) const { return D2; }
    __device__ __forceinline__ const char* b_base(const Unit& u) const { return ZT + (size_t)u.z * 256 * (2 * T * 2) + (size_t)u.pn * 512; }
    __device__ __forceinline__ void epi(Acc& acc, const Unit& u, int wr, int wc, int fr, int fq) const {
        const int k1 = u.pn >> 1, b = u.pn & 1;
#pragma unroll
        for (int m = 0; m < 4; ++m) { const int k2 = wr * 64 + m * 16 + fr; bf16_t* rp = F + (size_t)(b * SP + k1 + 128 * k2) * 1024 + u.z * 256 + wc * 32 + 8 * fq;
#pragma unroll
            for (int bj = 0; bj < 2; ++bj) { const f32x4 v0 = acc[0][bj][m][0], v1 = acc[0][bj][m][1]; u32x4 w;
                w.x = cvt_pk_bf16(v0[0], v0[1]); w.y = cvt_pk_bf16(v0[2], v0[3]); w.z = cvt_pk_bf16(v1[0], v1[1]); w.w = cvt_pk_bf16(v1[2], v1[3]);
                *(u32x4*)(rp + bj * 128) = w; } }
    }
};

__device__ __forceinline__ int crow(int r, int hi) { return (r & 3) + 8 * (r >> 2) + 4 * hi; }
struct AttnArgs {
    const bf16_t* QK; int ldq;
    const bf16_t* VT;
    bf16_t* O;
    int seq0, S, qpos0;
    int qcol0, kcol, vrow0, ocol0;
    int kt_lo, kt_hi;
    float sink2a, sink2b;
    float lam, post;
    const float* subg;
};
template <int MODE, bool TRACK>
__device__ __forceinline__ void attn_unit(unsigned char* lds, const AttnArgs& a) {
    constexpr int KW = MODE == 0 ? 64 : 128, DV = MODE == 0 ? 64 : 128, NDB = DV / 32, KPB = (KW + 8) * 2, VPB = 144, NLD = MODE == 0 ? 1 : 2;
    constexpr int KBUF = 64 * KPB, VBUF = DV * VPB;
    int tid = threadIdx.x; asm volatile("" : "+v"(tid));
    const int lane = tid & 63, r32 = lane & 31, hi = lane >> 5; const int wid = __builtin_amdgcn_readfirstlane(tid >> 6), wg = wid >> 2, wq = wid & 3;
    const int qrow = a.seq0 + a.qpos0 + wq * 32 + r32;
    bf16x8 qr[4];
    { const bf16_t* qp = a.QK + (size_t)qrow * a.ldq + a.qcol0 + wg * 64 + hi * 8;
#pragma unroll
      for (int d0 = 0; d0 < 4; ++d0) qr[d0] = *(const bf16x8*)(qp + d0 * 16); }
    const int coff = MODE == 0 ? 0 : wg * 64;
    const int qi = a.qpos0 + wq * 32 + r32;
    f32x16 o[NDB];
#pragma unroll
    for (int i = 0; i < NDB; ++i)
#pragma unroll
        for (int r = 0; r < 16; ++r) o[i][r] = 0.f;
    float mref = TRACK ? -1e30f : 0.f, lrun = 0.f;
    u32x4 kreg[NLD], vreg[NLD];
    const int NT = a.kt_hi - a.kt_lo;
    const unsigned koff = (unsigned)(((MODE == 0 ? tid >> 3 : tid >> 4) * a.ldq + (MODE == 0 ? tid & 7 : tid & 15) * 8) * 2);
    const unsigned voff = (unsigned)(((tid >> 3) * T + (tid & 7) * 8) * 2);
    auto gload_k = [&](int kt) {
        const char* kb = (const char*)a.QK + ((size_t)(a.seq0 + kt * 64) * a.ldq + a.kcol) * 2;
#pragma unroll
        for (int i = 0; i < NLD; ++i) kreg[i] = *(const u32x4*)(kb + (size_t)i * 32 * a.ldq * 2 + koff); };
    auto gload_v = [&](int kt) {
        const char* vb = (const char*)a.VT + ((size_t)a.vrow0 * T + a.seq0 + kt * 64) * 2;
#pragma unroll
        for (int i = 0; i < NLD; ++i) vreg[i] = *(const u32x4*)(vb + (size_t)i * 64 * T * 2 + voff); };
    auto st_k = [&](int buf) {
#pragma unroll
        for (int i = 0; i < NLD; ++i) { const int idx = tid + 512 * i; const int key = MODE == 0 ? idx >> 3 : idx >> 4, ch = MODE == 0 ? idx & 7 : idx & 15;
            *(u32x4*)(lds + buf * KBUF + key * KPB + ch * 16) = kreg[i]; } };
    auto st_v = [&](int buf) {
#pragma unroll
        for (int i = 0; i < NLD; ++i) { const int idx = tid + 512 * i; const int d = idx >> 3, ch = idx & 7;
            unsigned char* dp = lds + 2 * KBUF + buf * VBUF + d * VPB + (ch >> 1) * 32 + (ch & 1) * 8; *(u32x2*)dp = (u32x2){vreg[i].x, vreg[i].y}; *(u32x2*)(dp + 16) = (u32x2){vreg[i].z, vreg[i].w}; } };
    auto stepf = [&](int t, auto HASQK_, auto HASPV_, f32x16 (&p)[2], f32x16 (&s)[2]) {
        constexpr bool HASQK = decltype(HASQK_)::value, HASPV = decltype(HASPV_)::value;
        if (t + 1 < NT) gload_k(a.kt_lo + t + 1);
        if (t < NT) gload_v(a.kt_lo + t);
        const unsigned char* Ks = lds + (t & 1) * KBUF + r32 * KPB + (coff + 8 * hi) * 2;
        const unsigned char* Vs = lds + 2 * KBUF + ((t + 1) & 1) * VBUF + r32 * VPB + 16 * hi;
        const f32x16 zz = (f32x16){0.f, 0.f, 0.f, 0.f, 0.f, 0.f, 0.f, 0.f, 0.f, 0.f, 0.f, 0.f, 0.f, 0.f, 0.f, 0.f};
        bf16x8 kf[8]; bf16x8 pk[2][2]; u32x4 pw[2][2];
        if (HASQK) {
#pragma unroll
            for (int j = 0; j < 3; ++j) kf[j] = *(const bf16x8*)(Ks + (j >> 2) * 32 * KPB + (j & 3) * 32);
        }
        constexpr int NPV = 4 * NDB, EPG = 32 / NPV;
        bf16x8 vf[NPV];
        auto vread = [&](int jj) { const int i = jj >> 2, kb = (jj >> 1) & 1, kg = jj & 1; vf[jj] = *(const bf16x8*)(Vs + 32 * i * VPB + (32 * kb + 16 * kg) * 2); };
        if (HASPV) { vread(0); }
        float sum0 = 0.f, sum1 = 0.f;
#pragma unroll
        for (int j = 0; j < 8; ++j) {
            if (HASQK) { if (j + 3 < 8) kf[j + 3] = *(const bf16x8*)(Ks + ((j + 3) >> 2) * 32 * KPB + ((j + 3) & 3) * 32);
                s[j >> 2] = __builtin_amdgcn_mfma_f32_32x32x16_bf16(kf[j], qr[j & 3], (j & 3) == 0 ? zz : s[j >> 2], 0, 0, 0); }
            if (HASPV) { const int kb = j >> 2, e = (4 * j) & 15;
                sum0 += p[kb][e] + p[kb][e + 2]; sum1 += p[kb][e + 1] + p[kb][e + 3];
                const unsigned w0 = cvt_pk_bf16(p[kb][e], p[kb][e + 1]), w1 = cvt_pk_bf16(p[kb][e + 2], p[kb][e + 3]);
                if ((j & 1) == 0) { pw[kb][(j >> 1) & 1].x = w0; pw[kb][(j >> 1) & 1].y = w1; } else { pw[kb][(j >> 1) & 1].z = w0; pw[kb][(j >> 1) & 1].w = w1; } }
            __builtin_amdgcn_sched_barrier(0);
        }
        if (HASPV) { lrun += sum0 + sum1;
#pragma unroll
            for (int kb = 0; kb < 2; ++kb)
#pragma unroll
                for (int kg = 0; kg < 2; ++kg) pk[kb][kg] = __builtin_bit_cast(bf16x8, pw[kb][kg]); }
        bool resc = false; float alpha = 1.f;
        if (HASQK) {
            if (MODE == 0) { const int kp0 = (a.kt_lo + t) * 64;
#pragma unroll
                for (int kb = 0; kb < 2; ++kb)
#pragma unroll
                    for (int r = 0; r < 16; ++r) { const int dlt = qi - (kp0 + 32 * kb + crow(r, hi)); if (dlt > 128 || dlt < -128) s[kb][r] = -INFINITY; } }
            if (TRACK) {
            float m0 = fmaxf(fmaxf(s[0][0], s[0][1]), s[1][0]), m1 = fmaxf(fmaxf(s[0][2], s[0][3]), s[1][1]); m0 = fmaxf(fmaxf(m0, s[1][2]), s[1][3]);
#pragma unroll
            for (int r = 4; r < 16; r += 4) { m0 = fmaxf(fmaxf(m0, s[0][r]), s[0][r + 1]); m1 = fmaxf(fmaxf(m1, s[0][r + 2]), s[0][r + 3]); m0 = fmaxf(fmaxf(m0, s[1][r]), s[1][r + 1]); m1 = fmaxf(fmaxf(m1, s[1][r + 2]), s[1][r + 3]); }
            float rm = xor32_max(fmaxf(m0, m1));
            resc = __any(rm - mref > 8.0f);
            if (resc) { const float mnew = fmaxf(mref, rm); alpha = __builtin_amdgcn_exp2f(mref - mnew); mref = mnew; }
            }
        }
        __builtin_amdgcn_sched_barrier(0);
        if (HASPV) {
            vread(1);
#pragma unroll
            for (int jj = 0; jj < NPV; ++jj) {
                if (jj + 2 < NPV) vread(jj + 2);
                if (jj == NPV / 2) { if (t + 1 < NT) st_k((t + 1) & 1); if (t < NT) st_v(t & 1); }
                o[jj >> 2] = __builtin_amdgcn_mfma_f32_32x32x16_bf16(vf[jj], pk[(jj >> 1) & 1][jj & 1], o[jj >> 2], 0, 0, 0);
                if (HASQK) {
#pragma unroll
                    for (int q = 0; q < EPG; ++q) { const int e = jj * EPG + q; s[e >> 4][e & 15] = __builtin_amdgcn_exp2f(TRACK ? s[e >> 4][e & 15] - mref : s[e >> 4][e & 15]); }
                    asm volatile("" : "+v"(s[(jj * EPG) >> 4])); }
                __builtin_amdgcn_sched_barrier(0);
            }
        } else if (HASQK) {
#pragma unroll
            for (int e = 0; e < 32; ++e) s[e >> 4][e & 15] = __builtin_amdgcn_exp2f(TRACK ? s[e >> 4][e & 15] - mref : s[e >> 4][e & 15]);
        }
        if (resc) { lrun *= alpha;
#pragma unroll
            for (int i = 0; i < NDB; ++i)
#pragma unroll
                for (int r = 0; r < 16; ++r) o[i][r] *= alpha; }
        if (!HASPV) { if (t + 1 < NT) st_k((t + 1) & 1); if (t < NT) st_v(t & 1); }
        __syncthreads();
    };
    __syncthreads();
    gload_k(a.kt_lo); st_k(0);
    __syncthreads();
    f32x16 sA[2], sB[2];
    {
        const std::true_type TT{}; const std::false_type FF_{};
        stepf(0, TT, FF_, sB, sA);
        for (int t = 1; t < NT - 1; t += 2) { stepf(t, TT, TT, sA, sB); stepf(t + 1, TT, TT, sB, sA); }
        stepf(NT - 1, TT, TT, sA, sB);
        stepf(NT, FF_, TT, sB, sA);
    }
    const float ltot = xor32_sum(lrun);
    int t2 = tid; asm volatile("" : "+v"(t2));
    const int qrow_e = a.seq0 + a.qpos0 + ((t2 >> 6) & 3) * 32 + (t2 & 31);
    if (MODE == 0) {
        const float sk = wg == 0 ? a.sink2a : a.sink2b; const float mf = fmaxf(mref, sk), al = __builtin_amdgcn_exp2f(mref - mf);
        const float inv = al / (ltot * al + __builtin_amdgcn_exp2f(sk - mf));
        bf16_t* op = a.O + (size_t)qrow_e * 1024 + a.ocol0 + wg * 64 + 4 * hi;
#pragma unroll
        for (int i = 0; i < NDB; ++i)
#pragma unroll
            for (int rq = 0; rq < 4; ++rq) { u32x2 w; w.x = cvt_pk_bf16(o[i][4 * rq] * inv, o[i][4 * rq + 1] * inv); w.y = cvt_pk_bf16(o[i][4 * rq + 2] * inv, o[i][4 * rq + 3] * inv);
                *(u32x2*)(op + 32 * i + 8 * rq) = w; }
    } else {
        const float inv = 1.0f / ltot;
        float* X = (float*)lds;
        if (wg == 1) {
#pragma unroll
            for (int i = 0; i < NDB; ++i)
#pragma unroll
                for (int rq = 0; rq < 4; ++rq) *(f32x4*)(X + (wq * 32 + r32) * 132 + 32 * i + 8 * rq + 4 * hi) = (f32x4){o[i][4 * rq] * inv, o[i][4 * rq + 1] * inv, o[i][4 * rq + 2] * inv, o[i][4 * rq + 3] * inv};
        }
        __syncthreads();
        if (wg == 0) {
            float ss = 0.f;
#pragma unroll
            for (int i = 0; i < NDB; ++i)
#pragma unroll
                for (int rq = 0; rq < 4; ++rq) { const f32x4 x1 = *(const f32x4*)(X + (wq * 32 + r32) * 132 + 32 * i + 8 * rq + 4 * hi);
#pragma unroll
                    for (int j = 0; j < 4; ++j) { const float v = o[i][4 * rq + j] * inv - a.lam * x1[j]; o[i][4 * rq + j] = v; ss += v * v; } }
            ss = xor32_sum(ss);
            const float rs = rsqrtf(ss * (1.0f / 128.0f) + EPS) * a.post;
            bf16_t* op = a.O + (size_t)qrow_e * 1024 + a.ocol0 + 4 * hi;
#pragma unroll
            for (int i = 0; i < NDB; ++i)
#pragma unroll
                for (int rq = 0; rq < 4; ++rq) { const f32x4 g = *(const f32x4*)(a.subg + 32 * i + 8 * rq + 4 * hi); u32x2 w;
                    w.x = cvt_pk_bf16(o[i][4 * rq] * rs * g[0], o[i][4 * rq + 1] * rs * g[1]); w.y = cvt_pk_bf16(o[i][4 * rq + 2] * rs * g[2], o[i][4 * rq + 3] * rs * g[3]);
                    *(u32x2*)(op + 32 * i + 8 * rq) = w; }
        }
    }
}

__device__ __forceinline__ void transpose_item(const float* W, int K, int N, bf16_t* WT, int mode, float* scr, int item, int lane) {
    const int nblk = N / 32, kb = item / nblk, nb = item % nblk, k0 = 64 * kb, n0 = 32 * nb;
    const int drow = mode == 0 ? n0 : ((n0 >> 7) * 256 + (n0 & 127) + (mode == 2 ? 128 : 0));
#pragma unroll 8
    for (int i = 0; i < 32; ++i) { const int kk = 2 * i + (lane >> 5); scr[kk * 33 + (lane & 31)] = W[(size_t)(k0 + kk) * N + n0 + (lane & 31)]; }
    __builtin_amdgcn_fence(__ATOMIC_ACQ_REL, "wavefront"); asm volatile("s_waitcnt lgkmcnt(0)" ::: "memory");
    const int cc = lane & 7;
#pragma unroll
    for (int j = 0; j < 4; ++j) { const int n = (lane >> 3) + 8 * j; const float* s = scr + (8 * cc) * 33 + n;
        u32x4 o; o.x = cvt_pk_bf16(s[0 * 33], s[1 * 33]); o.y = cvt_pk_bf16(s[2 * 33], s[3 * 33]); o.z = cvt_pk_bf16(s[4 * 33], s[5 * 33]); o.w = cvt_pk_bf16(s[6 * 33], s[7 * 33]);
        *(u32x4*)(WT + (size_t)(drow + n) * K + k0 + 8 * cc) = o; }
    asm volatile("s_waitcnt lgkmcnt(0)" ::: "memory"); __builtin_amdgcn_fence(__ATOMIC_ACQ_REL, "wavefront");
}
__device__ __forceinline__ void prep_phase(const float* x0, const float* x1, const float* g, const float* modl, int shc, int scc, bf16_t* Hh, int gw, int ngw, int lane) {
    asm volatile("" : "+v"(lane));
    for (int row = gw; row < T; row += ngw) {
        const float* xr = (row < TP ? x0 + (size_t)row * 1024 : x1 + (size_t)(row - TP) * 1024);
        const float* mp = modl + (size_t)seq_of(row) * 6144;
        f32x4 v[4]; float s = 0.f;
#pragma unroll
        for (int j = 0; j < 4; ++j) { v[j] = *(const f32x4*)(xr + 4 * lane + 256 * j); s += (v[j][0] * v[j][0] + v[j][1] * v[j][1]) + (v[j][2] * v[j][2] + v[j][3] * v[j][3]); }
        const float rs = rsqrtf(wave_sum(s) * (1.0f / 1024.0f) + EPS);
#pragma unroll
        for (int j = 0; j < 4; ++j) { const int cidx = 4 * lane + 256 * j; const f32x4 gg = *(const f32x4*)(g + cidx), sc = *(const f32x4*)(mp + scc * 1024 + cidx), sh = *(const f32x4*)(mp + shc * 1024 + cidx);
            const f32x4 y = v[j] * rs * gg * (sc + 1.0f) + sh; u32x2 w; w.x = cvt_pk_bf16(y[0], y[1]); w.y = cvt_pk_bf16(y[2], y[3]);
            *(u32x2*)(Hh + (size_t)row * 1024 + cidx) = w; }
    }
}
template <int NCH>
__device__ __forceinline__ void qkpost_phase(bf16_t* QK, int ldq, int nq_heads, int nheads, const float* qg, const float* kg, const f32x2* RT, int gw, int ngw, int lane) {
    asm volatile("" : "+v"(lane));
    const int j = lane & 7, hl = lane >> 3;
    float gq8[8], gk8[8];
#pragma unroll
    for (int e = 0; e < 8; ++e) { gq8[e] = qg[8 * j + e] * (0.125f * LOG2E); gk8[e] = kg[8 * j + e]; }
    for (int row = gw; row < T; row += ngw) {
        bf16_t* rp = QK + (size_t)row * ldq + lane * 8;
        u32x4 xin[NCH];
#pragma unroll
        for (int c = 0; c < NCH; ++c) if (c * 8 + hl < nheads) xin[c] = *(const u32x4*)(rp + c * 512);
        const f32x4* rt = (const f32x4*)(RT + (size_t)pos_of(row) * 32 + 8 * (j & 3));
        const f32x4 t0 = rt[0], t1 = rt[1], t2 = rt[2], t3 = rt[3];
        const float cs[8] = {t0[0], t0[2], t1[0], t1[2], t2[0], t2[2], t3[0], t3[2]}, sn[8] = {t0[1], t0[3], t1[1], t1[3], t2[1], t2[3], t3[1], t3[3]};
#pragma unroll
        for (int c = 0; c < NCH; ++c) {
            const int head = c * 8 + hl;
            float x[8];
#pragma unroll
            for (int e = 0; e < 4; ++e) { x[2 * e] = __uint_as_float(xin[c][e] << 16); x[2 * e + 1] = __uint_as_float(xin[c][e] & 0xffff0000u); }
            float ss = 0.f;
#pragma unroll
            for (int e = 0; e < 8; ++e) ss += x[e] * x[e];
            ss += swz_xor<1>(ss); ss += swz_xor<2>(ss); ss += swz_xor<4>(ss);
            const float rs = rsqrtf(ss * (1.0f / 64.0f) + EPS);
            float ov[8];
#pragma unroll
            for (int e = 0; e < 8; ++e) { const float y = x[e] * rs * (head < nq_heads ? gq8[e] : gk8[e]); const float pr = swz_xor<4>(y);
                ov[e] = j < 4 ? (y * cs[e] - pr * sn[e]) : (y * cs[e] + pr * sn[e]); }
            u32x4 w; w.x = cvt_pk_bf16(ov[0], ov[1]); w.y = cvt_pk_bf16(ov[2], ov[3]); w.z = cvt_pk_bf16(ov[4], ov[5]); w.w = cvt_pk_bf16(ov[6], ov[7]);
            if (head < nheads) *(u32x4*)(rp + c * 512) = w;
        }
    }
}

#define XB_TMO      128
#define XB_XCNT(j)  (256  + 64 * (j))
#define XB_XSUB(j)  (1280 + 64 * (j))
#define XB_XGEN(j)  (2304 + 64 * (j))
#define XB_TOP      3328
#define XB_TOPGEN   3392
#define XCD_BAR_WORDS 3456
#define XB_SPIN_CAP (1u << 22)
__device__ __forceinline__ unsigned xb_ld(unsigned* p)              { return __hip_atomic_load(p, __ATOMIC_RELAXED, __HIP_MEMORY_SCOPE_AGENT); }
__device__ __forceinline__ unsigned xb_add(unsigned* p, unsigned v) { return __hip_atomic_fetch_add(p, v, __ATOMIC_RELAXED, __HIP_MEMORY_SCOPE_AGENT); }
__device__ __forceinline__ unsigned xb_xcc_id() { return (unsigned)__builtin_amdgcn_s_getreg((3 << 11) | 20) & 0xFu; }
#define XB_SPIN(cond, bar) do { unsigned _sp = 0; while (cond) { __builtin_amdgcn_s_sleep(1); \
    if ((++_sp & 255u) == 0u) { if (xb_ld(&(bar)[XB_TMO])) break; if (_sp > XB_SPIN_CAP) { atomicAdd(&(bar)[XB_TMO], 1u); break; } } } } while (0)
struct XcdBarrier { unsigned* bar; unsigned x; volatile LAS unsigned* st; };
__device__ __forceinline__ XcdBarrier xcd_barrier_post(unsigned* bar, volatile LAS unsigned* st) {
    XcdBarrier b; b.bar = bar; b.x = xb_xcc_id(); b.st = st;
    if (threadIdx.x == 0) (void)xb_add(&bar[XB_XCNT(b.x)], 1u);
    return b;
}
__device__ __forceinline__ void xcd_barrier_complete(unsigned* bar, unsigned x, unsigned& nloc, unsigned& nx) {
    const unsigned G = gridDim.x * gridDim.y * gridDim.z;
    unsigned sum, cnt, mine, sp = 0u;
    for (;;) {
        sum = 0u; cnt = 0u; mine = 0u;
#pragma unroll
        for (unsigned j = 0; j < 16; ++j) { const unsigned c = xb_ld(&bar[XB_XCNT(j)]); sum += c; cnt += (c > 0u) ? 1u : 0u; mine = (j == x) ? c : mine; }
        if (sum == G) break;
        __builtin_amdgcn_s_sleep(1);
        if ((++sp & 255u) == 0u) { if (xb_ld(&bar[XB_TMO])) break; if (sp > XB_SPIN_CAP) { atomicAdd(&bar[XB_TMO], 1u); break; } }
    }
    nloc = mine > 0u ? mine : 1u; nx = cnt > 0u ? cnt : 1u;
}
__device__ __forceinline__ void xcd_barrier(const XcdBarrier& b) {
    asm volatile("s_waitcnt vmcnt(0)" ::: "memory");
    __syncthreads();
    if (threadIdx.x == 0) {
        unsigned* bar = b.bar;
        __builtin_amdgcn_s_waitcnt(0);
        unsigned nloc = b.st[0], nx = b.st[1];
        if (nloc == 0u) { xcd_barrier_complete(bar, b.x, nloc, nx); b.st[0] = nloc; b.st[1] = nx; }
        const unsigned old = xb_add(&bar[XB_XSUB(b.x)], 1u);
        const unsigned gen = old / nloc;
        if (old + 1u == (gen + 1u) * nloc) {
            __builtin_amdgcn_fence(__ATOMIC_RELEASE, "agent");
            asm volatile("s_waitcnt vmcnt(0)" ::: "memory");
            const unsigned og = xb_add(&bar[XB_TOP], 1u);
            const unsigned tg = og / nx;
            if (og + 1u == (tg + 1u) * nx) xb_add(&bar[XB_TOPGEN], 1u);
            else XB_SPIN(xb_ld(&bar[XB_TOPGEN]) == tg, bar);
            __builtin_amdgcn_fence(__ATOMIC_ACQUIRE, "agent");
            xb_add(&bar[XB_XGEN(b.x)], 1u);
            asm volatile("s_waitcnt vmcnt(0)" ::: "memory");
        } else {
            XB_SPIN(xb_ld(&bar[XB_XGEN(b.x)]) == gen, bar);
            __builtin_amdgcn_fence(__ATOMIC_ACQUIRE, "agent");
            asm volatile("s_waitcnt vmcnt(0)" ::: "memory");
        }
    }
    __syncthreads();
}

#ifndef PHASES
#define PHASES 0xFFFFFF
#endif
#define EN(b) ((PHASES >> (b)) & 1)
struct Args { const float* in[29]; float* out; unsigned char* ws; };

__global__ void __launch_bounds__(512, 2) fwd_kernel(Args args) {
    extern __shared__ __attribute__((aligned(16))) unsigned char lds[];
    cg::grid_group grid = cg::this_grid();
    const int tid = threadIdx.x, lane = tid & 63, wave = __builtin_amdgcn_readfirstlane(tid >> 6);
    const int G = gridDim.x, bx = blockIdx.x;
    const int vcu = (G % 8 == 0) ? (bx % 8) * (G / 8) + bx / 8 : bx;
    const int gw = vcu * 8 + wave, ngw = G * 8;
    __builtin_assume(gw >= 0 && gw < 8192 && ngw >= 8 && ngw <= 8192 && G >= 1 && G <= 1024);
    const __attribute__((address_space(4))) Args* ap = (const __attribute__((address_space(4))) Args*)__builtin_amdgcn_kernarg_segment_ptr();
    asm volatile("" : "+s"(ap));
    unsigned long long wsi = (unsigned long long)ap->ws, outi = (unsigned long long)ap->out;
#define ws ((unsigned char*)(GAS unsigned char*)wsi)
#define out ((float*)(GAS float*)outi)
#define INP(i) ((const float*)(const GAS float*)(ap->in[i]))
    LAS unsigned char* lds3 = (LAS unsigned char*)lds;
#define mod ((float*)(ws + WS_MOD))
#define Hh ((bf16_t*)(ws + WS_H))
#define BIG ((bf16_t*)(ws + WS_BIG))
#define VTB ((bf16_t*)(ws + WS_VT))
#define Gh ((float*)(ws + WS_HALO))
#define RT ((const f32x2*)(ws + WS_ROPE))
#define OPQ() asm volatile("" : "+s"(wsi), "+s"(outi), "+s"(ap))
    if (tid < 16) ((LAS unsigned*)(lds3 + LDS_BYTES - 64))[tid] = 0u;
    __syncthreads();
    XcdBarrier xbar = xcd_barrier_post((unsigned*)ws, (volatile LAS unsigned*)(lds3 + LDS_BYTES - 64));
#define GSYNC() do { xcd_barrier(xbar); OPQ(); } while (0)

    if (EN(0)) {
        float* cact = (float*)lds;
        for (int idx = tid; idx < NSEQ * 1024; idx += 512) { const int b = idx >> 10, k = idx & 1023; const float cv = b < 2 ? INP(2)[b * 1024 + k] : INP(3)[(b - 2) * 1024 + k];
            cact[idx] = cv * __builtin_amdgcn_rcpf(1.0f + __expf(-cv)); }
        __syncthreads();
        {
            float* red = (float*)(lds + NSEQ * 1024 * 4);
            for (int item = bx; item < 384; item += G) {
                const int li = item / 96, n = (item % 96) * 64 + lane;
                const float* wp = INP(4) + ((size_t)li * 1024 + (size_t)wave * 128) * 6144 + n;
                float acc[NSEQ];
#pragma unroll
                for (int b = 0; b < NSEQ; ++b) acc[b] = 0.f;
                for (int k4 = 0; k4 < 32; ++k4) {
                    const float w0 = wp[(size_t)(4 * k4) * 6144], w1 = wp[(size_t)(4 * k4 + 1) * 6144], w2 = wp[(size_t)(4 * k4 + 2) * 6144], w3 = wp[(size_t)(4 * k4 + 3) * 6144];
#pragma unroll
                    for (int b = 0; b < NSEQ; ++b) { const f32x4 cv = *(const f32x4*)(cact + b * 1024 + wave * 128 + 4 * k4); acc[b] += (cv[0] * w0 + cv[1] * w1) + (cv[2] * w2 + cv[3] * w3); }
                }
                for (int r = 0; r < 8; ++r) {
                    if (wave == r) {
#pragma unroll
                        for (int b = 0; b < NSEQ; ++b) red[b * 64 + lane] = (r == 0 ? 0.f : red[b * 64 + lane]) + acc[b];
                    }
                    __syncthreads();
                }
                if (wave == 0) { const float bias = INP(5)[li * 6144 + n];
#pragma unroll
                    for (int b = 0; b < NSEQ; ++b) mod[(size_t)(li * NSEQ + b) * 6144 + n] = red[b * 64 + lane] + bias; }
                __syncthreads();
            }
        }
        __syncthreads();
        float* scr = (float*)(lds + wave * 16384);
        for (int mi = 0; mi < 18; ++mi) {
            const float* W; int K, N, mode = 0; bf16_t* WT;
            if (mi < 2) { W = INP(8) + (size_t)mi * 1024 * 1024; K = 1024; N = 1024; WT = (bf16_t*)(ws + WS_FNET) + (size_t)mi * 1024 * 1024; }
            else if (mi == 2) { W = INP(10); K = 1024; N = 1536; WT = (bf16_t*)(ws + WS_SWAQKV); }
            else if (mi == 3) { W = INP(14); K = 1024; N = 1024; WT = (bf16_t*)(ws + WS_SWAWO); }
            else if (mi == 4) { W = INP(15); K = 1024; N = 3072; WT = (bf16_t*)(ws + WS_DIFFQKV); }
            else if (mi == 5) { W = INP(23); K = 1024; N = 1024; WT = (bf16_t*)(ws + WS_DIFFWO); }
            else if (mi < 10) { const int l = mi - 6; W = INP(24) + (size_t)l * 1024 * FF; K = 1024; N = FF; WT = (bf16_t*)(ws + WS_GU + l * GU_STRIDE); mode = 1; }
            else if (mi < 14) { const int l = mi - 10; W = INP(25) + (size_t)l * 1024 * FF; K = 1024; N = FF; WT = (bf16_t*)(ws + WS_GU + l * GU_STRIDE); mode = 2; }
            else { const int l = mi - 14; W = INP(28) + (size_t)l * FF * 1024; K = FF; N = 1024; WT = (bf16_t*)(ws + WS_DOWN + l * DOWN_STRIDE); }
            const int nitems = (K / 64) * (N / 32);
            for (int it = gw; it < nitems; it += ngw) transpose_item(W, K, N, WT, mode, scr, it, lane);
        }
        const int gt = vcu * 512 + tid, ngt = G * 512;
        bf16_t* Dc = (bf16_t*)(ws + WS_DC); bf16_t* D1 = (bf16_t*)(ws + WS_D1); bf16_t* D2 = (bf16_t*)(ws + WS_D2);
        f32x2* TWp = (f32x2*)(ws + WS_TWP); f32x2* TWs = (f32x2*)(ws + WS_TWS); f32x2* RTw = (f32x2*)(ws + WS_ROPE);
        for (int e = gt; e < 512 * 256; e += ngt) { const int r = e >> 8, cc = e & 255, ri = r >> 8, kc = r & 255; const float rev = (float)((cc * kc) & 255) * (1.0f / 256.0f);
            const float v = ri == 0 ? __builtin_amdgcn_cosf(rev) : -__builtin_amdgcn_sinf(rev); Dc[e] = f2bf(v * 0.0625f); }
        const float r128 = 0.08838834764831845f;
        for (int e = gt; e < 256 * 256; e += ngt) { const int r = e >> 8, cc = e & 255, ro = r >> 7, k1 = r & 127, ri = cc >> 7, n1 = cc & 127; const float rev = (float)((n1 * k1) & 127) * (1.0f / 128.0f);
            const float cs = __builtin_amdgcn_cosf(rev), sn = __builtin_amdgcn_sinf(rev);
            const float v = ro == 0 ? (ri == 0 ? cs : sn) : (ri == 0 ? -sn : cs); D1[e] = f2bf(v * r128);
            const float v2 = ro == 0 ? (ri == 0 ? cs : sn) : 0.f; D2[e] = f2bf(v2 * r128); }
        for (int e = gt; e < 128 * 128; e += ngt) { const int k1 = e >> 7, n2 = e & 127; const float rev = (float)(n2 * k1) * (1.0f / 16384.0f); TWp[e] = (f32x2){__builtin_amdgcn_cosf(rev), __builtin_amdgcn_sinf(rev)}; }
        for (int e = gt; e < 128 * 16; e += ngt) { const int k1 = e >> 4, n2 = e & 15; const float rev = (float)(n2 * k1) * (1.0f / 2048.0f); TWs[e] = (f32x2){__builtin_amdgcn_cosf(rev), __builtin_amdgcn_sinf(rev)}; }
        for (int e = gt; e < SP * 32; e += ngt) { const int pos = e >> 5, i = e & 31; double iv = 1.0; if (i & 1) iv *= 0.7498942093324559; if (i & 2) iv *= 0.5623413251903491; if (i & 4) iv *= 0.31622776601683794; if (i & 8) iv *= 0.1; if (i & 16) iv *= 0.01;
            double rv = (double)pos * iv * 0.15915494309189535; rv -= floor(rv); const float rev = (float)rv;
            RTw[e] = (f32x2){__builtin_amdgcn_cosf(rev), __builtin_amdgcn_sinf(rev)}; }
    }
    grid.sync(); OPQ();

    for (int layer = 0; layer < 4; ++layer) {
        const int kind = layer % 3, jm = layer / 3;
        const float* modl = mod + (size_t)layer * NSEQ * 6144;
        const float* xs0 = layer == 0 ? INP(0) : out; const float* xs1 = layer == 0 ? INP(1) : out + (size_t)TP * 1024;
        if (EN(1)) prep_phase(xs0, xs1, INP(6) + layer * 1024, modl, 0, 1, Hh, gw, ngw, lane);
        GSYNC();
        const char* wo_w; const float* wo_b = nullptr;
        if (kind == 0) {
            for (int part = 0; part < 2; ++part) { ProbF0 p{256, (const char*)(ws + WS_DC), (const char*)Hh, BIG, part, G, bx}; if (EN(2)) pg8::gemm_phase(lds3, p); }
            GSYNC();
            { ProbF1 p{256, (const char*)(ws + WS_D1), BIG, (const f32x2*)(ws + WS_TWP), (const f32x2*)(ws + WS_TWS), G, bx}; if (EN(3)) pg8::gemm_phase(lds3, p); }
            GSYNC();
            { ProbF2p p{256, (const char*)(ws + WS_D2), (const char*)BIG, Hh, G, bx}; if (EN(4)) pg8::gemm_phase(lds3, p); }
            if (EN(5)) {
                constexpr float C16[16] = {1.f, 0.9238795325112867f, 0.7071067811865476f, 0.3826834323650898f, 0.f, -0.3826834323650898f, -0.7071067811865476f, -0.9238795325112867f,
                                           -1.f, -0.9238795325112867f, -0.7071067811865476f, -0.3826834323650898f, 0.f, 0.3826834323650898f, 0.7071067811865476f, 0.9238795325112867f};
                int tid2 = tid; asm volatile("" : "+v"(tid2));
                const int gt = vcu * 512 + tid2, ngt = G * 512;
                for (int it = gt; it < 128 * 32 * 1024; it += ngt) {
                    const int cch = it & 1023, b = (it >> 10) & 31, k1 = it >> 15;
                    const bf16_t* src = BIG + (size_t)cch * (2 * T) + 65536 + (size_t)(b >> 4) * 65536 + (size_t)(k1 * 16 + (b & 15)) * 32;
                    float yr[16], yi[16];
#pragma unroll
                    for (int q = 0; q < 4; ++q) { const u32x4 w = *(const u32x4*)(src + 8 * q);
#pragma unroll
                        for (int e = 0; e < 4; ++e) { const float lo = __uint_as_float(w[e] << 16), hv = __uint_as_float(w[e] & 0xffff0000u);
                            if (q < 2) { yr[8 * q + 2 * e] = lo; yr[8 * q + 2 * e + 1] = hv; } else { yi[8 * (q - 2) + 2 * e] = lo; yi[8 * (q - 2) + 2 * e + 1] = hv; } } }
                    bf16_t* dst = Hh + (size_t)(TP + b * SS + k1) * 1024 + cch;
#pragma unroll
                    for (int k2 = 0; k2 < 16; ++k2) { float acc = 0.f;
#pragma unroll
                        for (int n2 = 0; n2 < 16; ++n2) { const int mm = (n2 * k2) & 15; acc += yr[n2] * C16[mm] + yi[n2] * C16[(mm + 12) & 15]; }
                        dst[(size_t)(128 * k2) * 1024] = f2bf(acc * 0.25f); }
                }
            }
            GSYNC();
            wo_w = (const char*)(ws + WS_FNET + (size_t)jm * 1024 * 1024 * 2); wo_b = INP(9) + jm * 1024;
        } else if (kind == 1) {
            { ProbQKV p{1024, (const char*)Hh, (const char*)(ws + WS_SWAQKV), 5, 1, BIG, 1280, VTB, G, bx}; if (EN(6)) pg8::gemm_phase(lds3, p); }
            GSYNC();
            if (EN(7)) qkpost_phase<3>(BIG, 1280, 16, 20, INP(11), INP(12), RT, gw, ngw, lane);
            GSYNC();
            {
                AttnArgs a; a.QK = BIG; a.ldq = 1280; a.VT = VTB; a.O = Hh; a.lam = 0.f; a.post = 0.f; a.subg = nullptr;
                float gqm = 0.f, gkm = 0.f, skm = 0.f;
                for (int i = 0; i < 64; ++i) { gqm = fmaxf(gqm, fabsf(INP(11)[i])); gkm = fmaxf(gkm, fabsf(INP(12)[i])); }
                for (int i = 0; i < 16; ++i) skm = fmaxf(skm, fabsf(INP(13)[i]));
                const bool fast = (8.0f * LOG2E * gqm * gkm < 40.0f) && (skm * LOG2E < 40.0f);
                auto run_units = [&](auto TRK_) { constexpr bool TRK = decltype(TRK_)::value;
                for (int ph = 0; ph < 2; ++ph) {
                    const int NU = ph == 0 ? 2048 : 4096, nqb = ph == 0 ? 128 : 16;
                    const int u0 = (int)((long)NU * vcu / G), u1 = (int)((long)NU * (vcu + 1) / G);
                    for (int u = u0; u < u1; ++u) {
                        const int gp = u & 1, n = (u >> 1) % nqb, bk = (u >> 1) / nqb, kvh = bk & 3, b = bk >> 2;
                        a.S = ph == 0 ? SP : SS; a.seq0 = ph == 0 ? b * SP : TP + b * SS; a.qpos0 = n * 128;
                        const int hd0 = kvh * 4 + gp * 2;
                        a.qcol0 = hd0 * 64; a.kcol = 1024 + kvh * 64; a.vrow0 = kvh * 64; a.ocol0 = hd0 * 64;
                        const int lo = a.qpos0 - 128 < 0 ? 0 : a.qpos0 - 128, hi_ = a.qpos0 + 256 > a.S ? a.S : a.qpos0 + 256;
                        a.kt_lo = lo >> 6; a.kt_hi = hi_ >> 6;
                        a.sink2a = INP(13)[hd0] * LOG2E; a.sink2b = INP(13)[hd0 + 1] * LOG2E;
                        if (EN(8)) attn_unit<0, TRK>(lds, a);
                    }
                }
                };
                if (fast) run_units(std::false_type{}); else run_units(std::true_type{});
            }
            GSYNC();
            wo_w = (const char*)(ws + WS_SWAWO);
        } else {
            { ProbQKV p{1024, (const char*)Hh, (const char*)(ws + WS_DIFFQKV), 8, 4, BIG, 2048, VTB, G, bx}; if (EN(6)) pg8::gemm_phase(lds3, p); }
            GSYNC();
            if (EN(7)) qkpost_phase<4>(BIG, 2048, 16, 32, INP(16), INP(17), RT, gw, ngw, lane);
            GSYNC();
            {
                float d1 = 0.f, d2 = 0.f;
                for (int i = 0; i < 64; ++i) { d1 += INP(18)[i] * INP(19)[i]; d2 += INP(20)[i] * INP(21)[i]; }
                const float lambda_init = 0.8f - 0.6f * 0.5488116360940264f;
                AttnArgs a; a.QK = BIG; a.ldq = 2048; a.VT = VTB; a.O = Hh; a.lam = __expf(d1) - __expf(d2) + lambda_init; a.post = 1.0f - lambda_init; a.subg = INP(22);
                a.sink2a = 0.f; a.sink2b = 0.f;
                float gqm = 0.f, gkm = 0.f;
                for (int i = 0; i < 64; ++i) { gqm = fmaxf(gqm, fabsf(INP(16)[i])); gkm = fmaxf(gkm, fabsf(INP(17)[i])); }
                const bool fast = (8.0f * LOG2E * gqm * gkm < 40.0f);
                auto run_units = [&](auto TRK_) { constexpr bool TRK = decltype(TRK_)::value;
                for (int ph = 0; ph < 2; ++ph) {
                    const int NU = ph == 0 ? 2048 : 4096, nqb = ph == 0 ? 128 : 16;
                    const int u0 = (int)((long)NU * vcu / G), u1 = (int)((long)NU * (vcu + 1) / G);
                    for (int u = u0; u < u1; ++u) {
                        const int qb = u % nqb, pr = u / nqb, h = pr & 7, b = pr >> 3;
                        a.S = ph == 0 ? SP : SS; a.seq0 = ph == 0 ? b * SP : TP + b * SS; a.qpos0 = qb * 128;
                        a.qcol0 = h * 128; a.kcol = 1024 + h * 128; a.vrow0 = h * 128; a.ocol0 = h * 128;
                        a.kt_lo = 0; a.kt_hi = a.S >> 6;
                        if (EN(9)) attn_unit<1, TRK>(lds, a);
                    }
                }
                };
                if (fast) run_units(std::false_type{}); else run_units(std::true_type{});
            }
            GSYNC();
            wo_w = (const char*)(ws + WS_DIFFWO);
        }
        { ProbResid p{1024, (const char*)Hh, 2048u, wo_w, xs0, xs1, out, modl + 2 * 1024, wo_b, G, bx}; if (EN(10)) pg8::gemm_phase(lds3, p); }
        GSYNC();
        if (EN(1)) prep_phase(out, out + (size_t)TP * 1024, INP(7) + layer * 1024, modl, 3, 4, Hh, gw, ngw, lane);
        GSYNC();
        const char* gu = (const char*)(ws + WS_GU + layer * GU_STRIDE);
        { ProbHalo p{1024, (const char*)Hh, gu, Gh, G, bx}; if (EN(11)) pg8::gemm_phase(lds3, p); }
        GSYNC();
        { ProbGateUp p{1024, (const char*)Hh, gu, Gh, INP(26) + (size_t)layer * 3 * FF, INP(27) + (size_t)layer * FF, BIG, G, bx}; if (EN(12)) pg8::gemm_phase(lds3, p); }
        GSYNC();
        { ProbResid p{FF, (const char*)BIG, (unsigned)(FF * 2), (const char*)(ws + WS_DOWN + layer * DOWN_STRIDE), out, out + (size_t)TP * 1024, out, modl + 5 * 1024, nullptr, G, bx}; if (EN(13)) pg8::gemm_phase(lds3, p); }
        if (layer < 3) GSYNC();
    }
}

#undef ws
#undef out
#undef INP
#undef OPQ
#undef GSYNC
#undef mod
#undef Hh
#undef BIG
#undef VTB
#undef Gh
#undef RT
extern "C" void kernel_launch(void* const* d_in, const int* in_sizes, int n_in, void* d_out, int out_size, void* d_ws, size_t ws_size, hipStream_t stream) {
    static int grid = 0;
    if (grid == 0) {
        if (n_in != 29 || ws_size < WS_END) { fprintf(stderr, "kernel_launch: unexpected problem (n_in %d, ws %zu)\n", n_in, ws_size); grid = -1; return; }
        int dev = 0, cus = 0, per_cu = 0;
        hipGetDevice(&dev); hipDeviceGetAttribute(&cus, hipDeviceAttributeMultiprocessorCount, dev);
        hipFuncSetAttribute((const void*)fwd_kernel, hipFuncAttributeMaxDynamicSharedMemorySize, LDS_BYTES);
        if (hipOccupancyMaxActiveBlocksPerMultiprocessor(&per_cu, (const void*)fwd_kernel, 512, LDS_BYTES) != hipSuccess || per_cu < 1) per_cu = 1;
        (void)hipGetLastError();
        grid = cus * 1;
    }
    if (grid < 0) return;
    (void)hipMemsetAsync(d_ws, 0, 16384, stream);
    Args a{};
    for (int i = 0; i < 29; ++i) a.in[i] = (const float*)d_in[i];
    a.out = (float*)d_out; a.ws = (unsigned char*)d_ws;
    void* kargs[] = {&a};
    hipError_t e = hipLaunchCooperativeKernel((const void*)fwd_kernel, dim3(grid), dim3(512), kargs, LDS_BYTES, stream);
    if (e != hipSuccess) fprintf(stderr, "cooperative launch failed: %s (grid %d)\n", hipGetErrorString(e), grid);
}
```
